# Optimizing an MI355X kernel written in HIP

```python
import math
import jax, jax.numpy as jnp
from jax import lax
import numpy as np

D_MODEL = 1024
BATCH = 32
SEQ = 256
DEPTH = 2
DEC_BATCH = 4
DEC_SEQ = 4096
PAST_LEN = 256

GRID_W = 64
D_A = D_MODEL
HEAD_A = 64
H_A = D_A // HEAD_A
N_DIR = 2
W_LORA = 64
A_LORA = 64
G_LORA = 128
D_B = D_MODEL
CHUNK = 128
H_B = 8
HEAD_B = D_B // H_B
D_FF = 4 * D_MODEL
C_RWKV = 3 * D_A + N_DIR * (W_LORA + A_LORA) + G_LORA
D_IN = C_RWKV + 2 * D_B + 2 * D_MODEL
N_MOD = 6
EPS = 1e-6
GN_EPS = 64e-5
DECAY_SCALE = math.exp(-0.5)

kernel_name = 'hybrid_rwkv7_gmlp_diffusion_step'


def rmsnorm(x, g):
    xf = x.astype(jnp.float32)
    y = xf * lax.rsqrt(jnp.mean(xf * xf, axis=-1, keepdims=True) + EPS)
    return (y * g).astype(x.dtype)


def seq_shift(z):
    B, T, C = z.shape
    g = z.reshape(B, T, C // 2, 2)
    prev = jnp.pad(g[:, :-1, :, 0], ((0, 0), (1, 0), (0, 0)))
    nxt = jnp.pad(g[:, 1:, :, 1], ((0, 0), (0, 1), (0, 0)))
    return jnp.stack([prev, nxt], axis=-1).reshape(B, T, C)


def grid_shift(z):
    B, T, C = z.shape
    rows = T // GRID_W
    g = z.reshape(B, rows, GRID_W, C // 4, 4)
    left = jnp.pad(g[:, :, :-1, :, 0], ((0, 0), (0, 0), (1, 0), (0, 0)))
    right = jnp.pad(g[:, :, 1:, :, 1], ((0, 0), (0, 0), (0, 1), (0, 0)))
    up = jnp.pad(g[:, :-1, :, :, 2], ((0, 0), (1, 0), (0, 0), (0, 0)))
    down = jnp.pad(g[:, 1:, :, :, 3], ((0, 0), (0, 1), (0, 0), (0, 0)))
    return jnp.stack([left, right, up, down], axis=-1).reshape(B, T, C)


def _heads(t):
    return t.reshape(t.shape[:-1] + (H_A, HEAD_A))


def _bi_shared(t):
    return jnp.stack([t, jnp.flip(t, axis=1)])


def _bi_dir(t):
    return jnp.stack([t[0], jnp.flip(t[1], axis=1)])


def _rwkv_step(S, inp):
    r, w, k, v, neg_kk, b = inp
    sa = jnp.einsum('dbhij,dbhj->dbhi', S, neg_kk)
    S = S * w[..., None, :] + sa[..., :, None] * b[..., None, :] + v[..., :, None] * k[..., None, :]
    return S, jnp.einsum('dbhij,dbhj->dbhi', S, r)


def rwkv_branch(z, S0, p, l):
    B, T, _ = z.shape
    f32 = jnp.float32
    r, k, v, wd, ad, gd = jnp.split(
        z, [D_A, 2 * D_A, 3 * D_A, 3 * D_A + N_DIR * W_LORA, 3 * D_A + N_DIR * (W_LORA + A_LORA)], axis=-1)
    r, k, v = r.astype(f32), k.astype(f32), v.astype(f32)
    wd = jnp.tanh(wd.reshape(B, T, N_DIR, W_LORA).astype(f32))
    w_logit = p['w0'][l][:, None, None, :] + jnp.einsum('btdr,drc->dbtc', wd, p['w_up'][l])
    decay = jnp.exp(-DECAY_SCALE * jax.nn.sigmoid(w_logit))
    a = jax.nn.sigmoid(p['a0'][l][:, None, None, :] + jnp.einsum(
        'btdr,drc->dbtc', ad.reshape(B, T, N_DIR, A_LORA).astype(f32), p['a_up'][l]))
    g = jax.nn.sigmoid(gd.astype(f32)) @ p['g_up'][l]
    kk = _heads(k * p['k_k'][l])
    kk = kk * lax.rsqrt(jnp.sum(kk * kk, axis=-1, keepdims=True) + 1e-12)
    k_d = k[None] * (1 + (a - 1) * p['k_a'][l])
    rh, vh, k_dh = _heads(r), _heads(v), _heads(k_d)
    xs = (_bi_shared(rh), _bi_dir(_heads(decay)), _bi_dir(k_dh), _bi_shared(vh),
          _bi_shared(-kk), _bi_dir(_heads(a)) * _bi_shared(kk))
    xs = tuple(jnp.moveaxis(t, 2, 0) for t in xs)
    S_fin, ys = lax.scan(_rwkv_step, S0.astype(f32), xs)
    ys = jnp.moveaxis(ys, 0, 2)
    y = ys[0] + jnp.flip(ys[1], axis=1)
    mu = jnp.mean(y, axis=-1, keepdims=True)
    var = jnp.mean(jnp.square(y - mu), axis=-1, keepdims=True)
    y = (y - mu) * lax.rsqrt(var + GN_EPS) * _heads(p['lnx_g'][l]) + _heads(p['lnx_b'][l])
    bonus = jnp.einsum('dbthn,bthn->bth', k_dh * p['r_k'][l], rh)[..., None] * vh
    y = (y + bonus).reshape(B, T, D_A) * g
    return y.astype(z.dtype) @ p['w_branch_a'][l], S_fin


def chunk_mlp_branch(zu, zv, p, l):
    B, T, _ = zu.shape
    u = jax.nn.gelu(zu)
    v = jax.nn.gelu(zv).astype(jnp.float32)
    mu = jnp.mean(v, axis=-1, keepdims=True)
    var = jnp.mean(jnp.square(v - mu), axis=-1, keepdims=True)
    v = (v - mu) * lax.rsqrt(var + EPS) * p['ln_v_g'][l]
    vc = v.reshape(B, T // CHUNK, CHUNK, H_B, HEAD_B)
    s = jnp.einsum('hpq,bnqhc->bnphc', p['w_s'][l], vc) + jnp.transpose(p['b_s'][l])[:, :, None]
    y = u * s.reshape(B, T, D_B).astype(u.dtype)
    return y @ p['w_branch_b'][l]


def trunk_layer(x, cond, S0, shift_fn, p, l):
    mod = jax.nn.silu(cond) @ p['w_ada'][l] + p['b_ada'][l]
    sh1, sc1, g1, sh2, sc2, g2 = jnp.split(mod[:, None, :], N_MOD, axis=-1)
    h = rmsnorm(x, p['norm1_g'][l]) * (1 + sc1) + sh1
    z = h @ p['w_in'][l]
    z_rwkv, z_u, z_v, z_ga, z_gb = jnp.split(
        z, [C_RWKV, C_RWKV + D_B, C_RWKV + 2 * D_B, C_RWKV + 2 * D_B + D_MODEL], axis=-1)
    z_rwkv = z_rwkv + p['mu_shift'][l] * (shift_fn(z_rwkv) - z_rwkv)
    y_a, S_fin = rwkv_branch(z_rwkv, S0, p, l)
    y_b = chunk_mlp_branch(z_u, z_v, p, l)
    mixed = (jax.nn.sigmoid(z_ga) * y_a + jax.nn.sigmoid(z_gb) * y_b) @ p['w_out'][l]
    x = x + g1 * mixed
    h2 = rmsnorm(x, p['norm2_g'][l]) * (1 + sc2) + sh2
    x = x + g2 * (jnp.square(jax.nn.relu(h2 @ p['w1'][l])) @ p['w2'][l])
    return x, S_fin


def setup_inputs(seed: int = 0) -> dict:
    key = jax.random.key(seed)
    ks = jax.random.split(key, 32)
    f32 = jnp.float32

    def nrm(k, shape, scale):
        return jax.random.normal(k, shape, f32) * scale

    return {
        'x_prompt': nrm(ks[0], (BATCH, SEQ, D_MODEL), 1.0),
        'x_sample': nrm(ks[1], (DEC_BATCH, DEC_SEQ, D_MODEL), 1.0),
        'state_rwkv': nrm(ks[2], (DEC_BATCH, DEPTH, N_DIR, H_A, HEAD_A, HEAD_A), 0.5),
        'c': nrm(ks[3], (DEC_BATCH, D_MODEL), 1.0),
        'c_ctx': nrm(ks[4], (D_MODEL,), 1.0),
        'w_ada': nrm(ks[5], (DEPTH, D_MODEL, N_MOD * D_MODEL), 0.5 * D_MODEL ** -0.5),
        'b_ada': nrm(ks[6], (DEPTH, N_MOD * D_MODEL), 0.02),
        'norm1_g': 1.0 + nrm(ks[7], (DEPTH, D_MODEL), 0.02),
        'norm2_g': 1.0 + nrm(ks[8], (DEPTH, D_MODEL), 0.02),
        'w_in': nrm(ks[9], (DEPTH, D_MODEL, D_IN), D_MODEL ** -0.5),
        'mu_shift': jax.random.uniform(ks[10], (DEPTH, C_RWKV), f32),
        'w0': nrm(ks[11], (DEPTH, N_DIR, D_A), 0.5),
        'w_up': nrm(ks[12], (DEPTH, N_DIR, W_LORA, D_A), 0.5 * W_LORA ** -0.5),
        'a0': nrm(ks[13], (DEPTH, N_DIR, D_A), 0.5),
        'a_up': nrm(ks[14], (DEPTH, N_DIR, A_LORA, D_A), 0.5 * A_LORA ** -0.5),
        'g_up': nrm(ks[15], (DEPTH, G_LORA, D_A), G_LORA ** -0.5),
        'k_k': 0.85 + nrm(ks[16], (DEPTH, D_A), 0.05),
        'k_a': 1.0 + nrm(ks[17], (DEPTH, D_A), 0.05),
        'r_k': nrm(ks[18], (DEPTH, H_A, HEAD_A), 0.1),
        'lnx_g': 1.0 + nrm(ks[19], (DEPTH, D_A), 0.02),
        'lnx_b': nrm(ks[20], (DEPTH, D_A), 0.02),
        'w_branch_a': nrm(ks[21], (DEPTH, D_A, D_MODEL), D_A ** -0.5),
        'ln_v_g': 1.0 + nrm(ks[22], (DEPTH, D_B), 0.02),
        'w_s': nrm(ks[23], (DEPTH, H_B, CHUNK, CHUNK), 0.5 * CHUNK ** -0.5),
        'b_s': 1.0 + nrm(ks[24], (DEPTH, H_B, CHUNK), 0.02),
        'w_branch_b': nrm(ks[25], (DEPTH, D_B, D_MODEL), D_B ** -0.5),
        'w_out': nrm(ks[26], (DEPTH, D_MODEL, D_MODEL), D_MODEL ** -0.5),
        'w1': nrm(ks[27], (DEPTH, D_MODEL, D_FF), D_MODEL ** -0.5),
        'w2': nrm(ks[28], (DEPTH, D_FF, D_MODEL), D_FF ** -0.5),
        'final_g': 1.0 + nrm(ks[29], (D_MODEL,), 0.02),
    }


def reference(x_prompt, x_sample, state_rwkv, c, c_ctx, w_ada, b_ada, norm1_g, norm2_g, w_in, mu_shift,
              w0, w_up, a0, a_up, g_up, k_k, k_a, r_k, lnx_g, lnx_b, w_branch_a, ln_v_g, w_s, b_s,
              w_branch_b, w_out, w1, w2, final_g):
    p = dict(w_ada=w_ada, b_ada=b_ada, norm1_g=norm1_g, norm2_g=norm2_g, w_in=w_in, mu_shift=mu_shift,
             w0=w0, w_up=w_up, a0=a0, a_up=a_up, g_up=g_up, k_k=k_k, k_a=k_a, r_k=r_k, lnx_g=lnx_g,
             lnx_b=lnx_b, w_branch_a=w_branch_a, ln_v_g=ln_v_g, w_s=w_s, b_s=b_s, w_branch_b=w_branch_b,
             w_out=w_out, w1=w1, w2=w2)
    B_ctx = x_prompt.shape[0]
    S_zero = jnp.zeros((N_DIR, B_ctx, H_A, HEAD_A, HEAD_A), jnp.float32)
    xp, xs = x_prompt, x_sample
    ctx_states = []
    for l in range(DEPTH):
        xp, S_ctx = trunk_layer(xp, c_ctx[None, :], S_zero, seq_shift, p, l)
        ctx_states.append(jnp.moveaxis(S_ctx, 0, 1))
        S_lat0 = jnp.moveaxis(state_rwkv[:, l], 1, 0)
        xs, _ = trunk_layer(xs, c, S_lat0, grid_shift, p, l)
    y_prompt = rmsnorm(xp, final_g)
    y_sample = rmsnorm(xs, final_g)
    new_state_rwkv = jnp.stack(ctx_states, axis=1)
    return (y_prompt, y_sample, new_state_rwkv)
```

```cpp
#include <hip/hip_runtime.h>
#include <hip/hip_cooperative_groups.h>
#include <cstdio>
#include <cstdint>
namespace cg = cooperative_groups;

#ifndef MK_PER_PHASE
#define MK_PER_PHASE 1
#endif

namespace pg8 {
#define PG8_LAS __attribute__((address_space(3)))
typedef _Float16 f16_t;
typedef _Float16 f16x8 __attribute__((ext_vector_type(8)));
typedef float f32x4 __attribute__((ext_vector_type(4)));
typedef unsigned u32x4 __attribute__((ext_vector_type(4)));
constexpr int BM = 256, BK = 64, HALF = 128, HTB = HALF * BK * 2  , STAGE_BYTES = 8 * HTB, NXCD = 8, WGM = 8;

__host__ __device__ __forceinline__ int lds_byte(int r, int c) { const int st = (r >> 4) * 2 + (c >> 5), rr = r & 15, cc = c & 31, ob = rr * 64 + cc * 2; return st * 1024 + (ob ^ (((ob >> 9) & 1) << 5)); }
__host__ __device__ __forceinline__ void stage_rc(int b, int& R, int& C) { const int st = b / 1024, sb = b % 1024, swz = sb ^ (((sb >> 9) & 1) << 5); R = (st >> 1) * 16 + swz / 64; C = (st & 1) * 32 + (swz % 64) / 2; }
__host__ __device__ __forceinline__ int perm32(int rho) { const int n = rho >> 4, i = rho & 15; return 8 * (i >> 2) + 4 * n + (i & 3); }

struct Unit { int pm, pn; };
struct Gemm { const f16_t* A; const f16_t* Bt; int M, N, K; };

struct StaticOrder {
    int nM, nN, nwg, G, c;
    __host__ __device__ void init(int M, int N, int G_, int c_) { nM = M / BM; nN = N / BM; nwg = nM * nN; G = G_; c = c_; }
    __host__ __device__ bool next(int i, Unit& u) const {
        const long L = (long)i * G + c; if (L >= nwg) return false;
        int wgid = (int)L; { const int q = nwg / NXCD, r = nwg % NXCD, xcd = wgid % NXCD, off = wgid / NXCD; wgid = (xcd < r ? xcd * (q + 1) : r * (q + 1) + (xcd - r) * q) + off; }
        const int nig = WGM * nN, gid = wgid / nig, fm = gid * WGM, gsz = (nM - fm) < WGM ? (nM - fm) : WGM;
        u.pm = fm + ((wgid % nig) % gsz); u.pn = (wgid % nig) / gsz; return true;
    }
    __device__ __forceinline__ void a_ready(const Unit&) const {}
    __device__ __forceinline__ void done(const Unit&) const {}
};

typedef _Float16 f16x2 __attribute__((ext_vector_type(2)));
typedef float f32x2 __attribute__((ext_vector_type(2)));
__device__ __forceinline__ unsigned pk_f16(float lo, float hi) { f32x2 v = {lo, hi}; f16x2 h = __builtin_convertvector(v, f16x2); return __builtin_bit_cast(unsigned, h); }
__device__ __forceinline__ float f16lo(unsigned w) { f16x2 h = __builtin_bit_cast(f16x2, w); return (float)h.x; }
__device__ __forceinline__ float f16hi(unsigned w) { f16x2 h = __builtin_bit_cast(f16x2, w); return (float)h.y; }
__device__ __forceinline__ float fast_sigmoid(float x) { return __builtin_amdgcn_rcpf(1.0f + __expf(-x)); }
__device__ __forceinline__ float gelu_tanh(float x) { const float y = 1.5957691216057308f * (x + 0.044715f * x * x * x); return x * __builtin_amdgcn_rcpf(1.0f + __expf(-y)); }
template <int ACT> __device__ __forceinline__ float act_fn(float x) {
    if (ACT == 1) return gelu_tanh(x);
    if (ACT == 2) return fast_sigmoid(x);
    if (ACT == 3) { const float r = x > 0.f ? x : 0.f; return r * r; }
    return x;
}
template <int ACT> struct EpiH16 {
    static constexpr bool PERM = true, AFTER_DRAIN = false;
    f16_t* O; int ldc; int split_cols; size_t split_stride;
    __device__ __forceinline__ void operator()(const f32x4 (&acc)[2][2][4][2], const Unit& u, int wr, int wc, int fr, int fq) const {
        const int row0 = u.pm * BM + wr * 64 + fr; int colt = u.pn * BM; f16_t* base = O;
        if (split_cols) { const int t = colt / split_cols; base += (size_t)t * split_stride; colt -= t * split_cols; }
        const int col0 = colt + wc * 32 + 8 * fq;
#pragma unroll
        for (int ai = 0; ai < 2; ++ai)
#pragma unroll
            for (int m = 0; m < 4; ++m) { f16_t* rowp = base + (size_t)(row0 + ai * HALF + m * 16) * ldc + col0;
#pragma unroll
                for (int bj = 0; bj < 2; ++bj) { const f32x4 v0 = acc[ai][bj][m][0], v1 = acc[ai][bj][m][1];
                    u32x4 w; w.x = pk_f16(act_fn<ACT>(v0[0]), act_fn<ACT>(v0[1])); w.y = pk_f16(act_fn<ACT>(v0[2]), act_fn<ACT>(v0[3]));
                    w.z = pk_f16(act_fn<ACT>(v1[0]), act_fn<ACT>(v1[1])); w.w = pk_f16(act_fn<ACT>(v1[2]), act_fn<ACT>(v1[3]));
                    *(u32x4*)(rowp + bj * HALF) = w; } }
    }
};
template <bool ADD> struct EpiMix {
    static constexpr bool PERM = true, AFTER_DRAIN = false;
    f16_t* MIX; const f16_t* G; int gcol;
    __device__ __forceinline__ void operator()(const f32x4 (&acc)[2][2][4][2], const Unit& u, int wr, int wc, int fr, int fq) const {
        const int row0 = u.pm * BM + wr * 64 + fr; const int col0 = u.pn * BM + wc * 32 + 8 * fq;
#pragma unroll
        for (int ai = 0; ai < 2; ++ai)
#pragma unroll
            for (int m = 0; m < 4; ++m) { const size_t row = (size_t)(row0 + ai * HALF + m * 16);
#pragma unroll
                for (int bj = 0; bj < 2; ++bj) { const f32x4 v0 = acc[ai][bj][m][0], v1 = acc[ai][bj][m][1];
                    const u32x4 g = *(const u32x4*)(G + row * 2048 + gcol + col0 + bj * HALF);
                    float o[8] = {v0[0] * f16lo(g.x), v0[1] * f16hi(g.x), v0[2] * f16lo(g.y), v0[3] * f16hi(g.y), v1[0] * f16lo(g.z), v1[1] * f16hi(g.z), v1[2] * f16lo(g.w), v1[3] * f16hi(g.w)};
                    f16_t* p = MIX + row * 1024 + col0 + bj * HALF;
                    if (ADD) { const u32x4 q = *(const u32x4*)p; o[0] += f16lo(q.x); o[1] += f16hi(q.x); o[2] += f16lo(q.y); o[3] += f16hi(q.y); o[4] += f16lo(q.z); o[5] += f16hi(q.z); o[6] += f16lo(q.w); o[7] += f16hi(q.w); }
                    u32x4 w; w.x = pk_f16(o[0], o[1]); w.y = pk_f16(o[2], o[3]); w.z = pk_f16(o[4], o[5]); w.w = pk_f16(o[6], o[7]);
                    *(u32x4*)p = w; } }
    }
};
struct EpiRes {
    static constexpr bool PERM = false, AFTER_DRAIN = false;
    const float* base_ctx; const float* base_lat; float* X; const float* gate;
    __device__ __forceinline__ void operator()(const f32x4 (&acc)[2][2][4][2], const Unit& u, int wr, int wc, int fr, int fq) const {
        const int row0 = u.pm * BM + wr * 64 + fr, col0 = u.pn * BM + wc * 32 + 4 * fq;
        const int s = u.pm < 32 ? 0 : 1 + ((u.pm - 32) >> 4);
        const float* gp = gate + s * 6144 + col0;
        f32x4 gv[2][2];
#pragma unroll
        for (int bj = 0; bj < 2; ++bj)
#pragma unroll
            for (int n = 0; n < 2; ++n) gv[bj][n] = *(const f32x4*)(gp + bj * HALF + n * 16);
#pragma unroll
        for (int ai = 0; ai < 2; ++ai)
#pragma unroll
            for (int m = 0; m < 4; ++m) { const int row = row0 + ai * HALF + m * 16;
                const float* bp = (row < 8192 ? base_ctx + (size_t)row * 1024 : base_lat + (size_t)(row - 8192) * 1024) + col0;
                float* xp = X + (size_t)row * 1024 + col0;
#pragma unroll
                for (int bj = 0; bj < 2; ++bj)
#pragma unroll
                    for (int n = 0; n < 2; ++n) { const f32x4 b = *(const f32x4*)(bp + bj * HALF + n * 16); *(f32x4*)(xp + bj * HALF + n * 16) = b + gv[bj][n] * acc[ai][bj][m][n]; } }
    }
};

template <class Epi, class Sched, bool ALIGN_EPI = false, bool SP2 = false>
__device__ __forceinline__ void gemm_phase(PG8_LAS unsigned char* lds, const Gemm g, const Sched& S, const Epi& E) {
    const int tid = threadIdx.x, wid = __builtin_amdgcn_readfirstlane(tid >> 6), lane = tid & 63, wr = wid >> 2, wc = wid & 3, fr = lane & 15, fq = lane >> 4;
    const int K = g.K, nt = K / BK;
    unsigned voffA[2], voffB[2];
#pragma unroll
    for (int i = 0; i < 2; ++i) { int R, C; stage_rc(tid * 16 + i * 8192, R, C); const int Rb = Epi::PERM ? ((R & ~31) + perm32(R & 31)) : R;
        voffA[i] = (unsigned)(R * K + C) * 2u; voffB[i] = (unsigned)(Rb * K + C) * 2u; }
    const size_t kstep = (size_t)(BK * 2);
    const size_t hstep = (size_t)HALF * K * 2;
    const size_t tstep = 2 * hstep;
    const unsigned ldsw = (unsigned)wid * 1024u;
    const int aoff = lds_byte(wr * 64 + fr, fq * 8), boff = lds_byte(wc * 32 + fr, fq * 8);
#define PG8_SA(b, h) (((b) * 2 + (h)) * HTB)
#define PG8_SB(b, h) ((4 + (b) * 2 + (h)) * HTB)
#define PG8_STAGE(bufoff, gbase, voff) do { _Pragma("unroll") for (int _i = 0; _i < 2; ++_i) \
        __builtin_amdgcn_global_load_lds((const unsigned*)((const char*)(gbase) + (voff)[_i]), (PG8_LAS unsigned*)(lds + (bufoff) + ldsw + _i * 8192), 16, 0, 0); } while (0)
#define PG8_LDA(dst, b, h) do { _Pragma("unroll") for (int m = 0; m < 4; ++m) _Pragma("unroll") for (int k = 0; k < 2; ++k) dst[m][k] = *(const PG8_LAS f16x8*)(lds + PG8_SA(b, h) + aoff + m * 2048 + k * 1024); } while (0)
#define PG8_LDB(dst, b, h) do { _Pragma("unroll") for (int n = 0; n < 2; ++n) _Pragma("unroll") for (int k = 0; k < 2; ++k) dst[n][k] = *(const PG8_LAS f16x8*)(lds + PG8_SB(b, h) + boff + n * 2048 + k * 1024); } while (0)
#define PG8_MMA(ai, bj, At, Bt) do { __builtin_amdgcn_s_setprio(1); _Pragma("unroll") for (int m = 0; m < 4; ++m) _Pragma("unroll") for (int n = 0; n < 2; ++n) _Pragma("unroll") for (int k = 0; k < 2; ++k) \
        acc[ai][bj][m][n] = __builtin_amdgcn_mfma_f32_16x16x32_f16(Bt[n][k], At[m][k], acc[ai][bj][m][n], 0, 0, 0); __builtin_amdgcn_s_setprio(0); } while (0)
#define PG8_WAIT_V(n) asm volatile("s_waitcnt vmcnt(" #n ")" ::: "memory")
#define PG8_WAIT_L(n) asm volatile("s_waitcnt lgkmcnt(" #n ")" ::: "memory")
#define PG8_BAR __builtin_amdgcn_s_barrier()
#define PG8_SCHED __builtin_amdgcn_sched_barrier(0)
    Unit cur, nxt; int ui = 0;
    if (!S.next(0, cur)) return;
    f32x4 acc[2][2][4][2];
#pragma unroll
    for (int a = 0; a < 2; ++a)
#pragma unroll
        for (int b = 0; b < 2; ++b)
#pragma unroll
            for (int m = 0; m < 4; ++m)
#pragma unroll
                for (int n = 0; n < 2; ++n) acc[a][b][m][n] = (f32x4){0.f, 0.f, 0.f, 0.f};
    f16x8 At[4][2], B0[2][2], B1[2][2];
    const char* cA = (const char*)g.A + (size_t)cur.pm * tstep; const char* cB = (const char*)g.Bt + (size_t)cur.pn * tstep;
    S.a_ready(cur);
    if constexpr (SP2) {
        PG8_STAGE(PG8_SB(0, 0), cB, voffB); PG8_STAGE(PG8_SB(0, 1), cB + hstep, voffB); PG8_STAGE(PG8_SA(0, 0), cA, voffA); PG8_STAGE(PG8_SA(0, 1), cA + hstep, voffA);
        if (wr == 1) PG8_BAR;
        PG8_WAIT_V(2); PG8_BAR;
        PG8_STAGE(PG8_SB(1, 0), cB + kstep, voffB); PG8_STAGE(PG8_SA(1, 0), cA + kstep, voffA); PG8_STAGE(PG8_SB(1, 1), cB + hstep + kstep, voffB);
        PG8_WAIT_V(6); PG8_BAR;
    } else {
        PG8_STAGE(PG8_SB(0, 0), cB, voffB); PG8_STAGE(PG8_SA(0, 0), cA, voffA); PG8_STAGE(PG8_SB(0, 1), cB + hstep, voffB); PG8_STAGE(PG8_SA(0, 1), cA + hstep, voffA);
        if (wr == 1) PG8_BAR;
        PG8_WAIT_V(4); PG8_BAR;
        PG8_STAGE(PG8_SB(1, 0), cB + kstep, voffB); PG8_STAGE(PG8_SA(1, 0), cA + kstep, voffA); PG8_STAGE(PG8_SB(1, 1), cB + hstep + kstep, voffB);
        PG8_WAIT_V(6); PG8_BAR;
    }
    for (;;) {
        const bool has_next = S.next(ui + 1, nxt);
        const char* nA = has_next ? (const char*)g.A + (size_t)nxt.pm * tstep : cA; const char* nB = has_next ? (const char*)g.Bt + (size_t)nxt.pn * tstep : cB;
        for (int t = 0; t < nt; t += 2) {
            const bool last = (t == nt - 2);
            const char* a1 = cA + (size_t)(t + 1) * kstep;
            const char* a2 = last ? nA : cA + (size_t)(t + 2) * kstep; const char* b2 = last ? nB : cB + (size_t)(t + 2) * kstep;
            const char* a3 = a2 + kstep; const char* b3 = b2 + kstep;
            if (last && has_next) S.a_ready(nxt);
            if constexpr (SP2) {
            PG8_LDB(B0, 0, 0); PG8_LDB(B1, 0, 1); PG8_SCHED; PG8_LDA(At, 0, 0); PG8_STAGE(PG8_SA(1, 1), a1 + hstep, voffA);
            PG8_WAIT_V(8); PG8_WAIT_L(0); PG8_BAR; PG8_MMA(0, 0, At, B0); PG8_MMA(0, 1, At, B1); PG8_BAR; PG8_SCHED;
            PG8_LDA(At, 0, 1); PG8_STAGE(PG8_SB(0, 0), b2, voffB); PG8_STAGE(PG8_SB(0, 1), b2 + hstep, voffB); PG8_STAGE(PG8_SA(0, 0), a2, voffA);
            PG8_WAIT_V(8); PG8_WAIT_L(0); PG8_BAR; PG8_MMA(1, 0, At, B0); PG8_MMA(1, 1, At, B1); PG8_BAR; PG8_SCHED;
            PG8_LDB(B0, 1, 0); PG8_LDB(B1, 1, 1); PG8_SCHED; PG8_LDA(At, 1, 0); PG8_STAGE(PG8_SA(0, 1), a2 + hstep, voffA);
            PG8_WAIT_V(8); PG8_WAIT_L(0); PG8_BAR; PG8_MMA(0, 0, At, B0); PG8_MMA(0, 1, At, B1); PG8_BAR; PG8_SCHED;
            PG8_LDA(At, 1, 1); PG8_STAGE(PG8_SB(1, 0), b3, voffB); PG8_STAGE(PG8_SB(1, 1), b3 + hstep, voffB); PG8_STAGE(PG8_SA(1, 0), a3, voffA);
            PG8_WAIT_V(8); PG8_WAIT_L(0); PG8_BAR; PG8_MMA(1, 0, At, B0); PG8_MMA(1, 1, At, B1); PG8_BAR; PG8_SCHED;
            } else {
            PG8_LDB(B0, 0, 0); PG8_SCHED; PG8_LDA(At, 0, 0); PG8_STAGE(PG8_SA(1, 1), a1 + hstep, voffA);
            PG8_WAIT_L(8); PG8_BAR; PG8_WAIT_L(0); PG8_MMA(0, 0, At, B0); PG8_BAR; PG8_SCHED;
            PG8_LDB(B1, 0, 1); PG8_STAGE(PG8_SB(0, 0), b2, voffB);
            PG8_BAR; PG8_WAIT_L(0); PG8_MMA(0, 1, At, B1); PG8_BAR;
            PG8_LDA(At, 0, 1); PG8_STAGE(PG8_SA(0, 0), a2, voffA);
            PG8_BAR; PG8_WAIT_L(0); PG8_MMA(1, 0, At, B0); PG8_BAR; PG8_SCHED;
            PG8_STAGE(PG8_SB(0, 1), b2 + hstep, voffB);
            PG8_WAIT_V(6); PG8_BAR; PG8_MMA(1, 1, At, B1); PG8_BAR;
            PG8_LDB(B0, 1, 0); PG8_SCHED; PG8_LDA(At, 1, 0); PG8_STAGE(PG8_SA(0, 1), a2 + hstep, voffA);
            PG8_WAIT_L(8); PG8_BAR; PG8_WAIT_L(0); PG8_MMA(0, 0, At, B0); PG8_BAR; PG8_SCHED;
            PG8_LDB(B1, 1, 1); PG8_STAGE(PG8_SB(1, 0), b3, voffB);
            PG8_BAR; PG8_WAIT_L(0); PG8_MMA(0, 1, At, B1); PG8_BAR;
            PG8_LDA(At, 1, 1); PG8_STAGE(PG8_SA(1, 0), a3, voffA);
            PG8_BAR; PG8_WAIT_L(0); PG8_MMA(1, 0, At, B0); PG8_BAR; PG8_SCHED;
            PG8_STAGE(PG8_SB(1, 1), b3 + hstep, voffB);
            PG8_WAIT_V(6); PG8_BAR; PG8_MMA(1, 1, At, B1); PG8_BAR;
            }
        }
        if constexpr (ALIGN_EPI) { if (wr == 0) PG8_BAR; }
        if constexpr (!Epi::AFTER_DRAIN) { E(acc, cur, wr, wc, fr, fq); S.done(cur); }
        if (!has_next) break;
#pragma unroll
        for (int a = 0; a < 2; ++a)
#pragma unroll
            for (int b = 0; b < 2; ++b)
#pragma unroll
                for (int m = 0; m < 4; ++m)
#pragma unroll
                    for (int n = 0; n < 2; ++n) acc[a][b][m][n] = (f32x4){0.f, 0.f, 0.f, 0.f};
        cur = nxt; cA = nA; cB = nB; ++ui;
        if constexpr (ALIGN_EPI) { if (wr == 1) PG8_BAR; }
    }
    PG8_WAIT_V(0);
    if constexpr (!ALIGN_EPI) { if (wr == 0) PG8_BAR; }
    PG8_BAR;
    if constexpr (Epi::AFTER_DRAIN) { E.fused(acc, cur, wr, wc, fr, fq, lds, wid, lane); S.done(cur); }
#undef PG8_SA
#undef PG8_SB
#undef PG8_STAGE
#undef PG8_LDA
#undef PG8_LDB
#undef PG8_MMA
#undef PG8_WAIT_V
#undef PG8_WAIT_L
#undef PG8_BAR
#undef PG8_SCHED
}
}

constexpr int NWAVES = 8, NTHR = 512;
constexpr int D = 1024, MCTX = 8192, MLAT = 16384, M = MCTX + MLAT;
constexpr int TCTX = 256, TLAT = 4096, BCTX = 32, BLAT = 4, NH = 16, HD = 64;
constexpr int DIN = 7552, CRW = 3456, ZRN = 3584, DFF = 4096;
constexpr int NLAYER = 2;
constexpr float EPS = 1e-6f, GN_EPS = 64e-5f, DECAY_SCALE = 0.6065306597126334f;
enum { I_XP = 0, I_XS, I_STATE, I_C, I_CCTX, I_WADA, I_BADA, I_N1G, I_N2G, I_WIN, I_MU, I_W0, I_WUP, I_A0, I_AUP, I_GUP, I_KK, I_KA, I_RK, I_LNXG, I_LNXB, I_WBA, I_LNVG, I_WS, I_BS, I_WBB, I_WOUT, I_W1, I_W2, I_FING, N_IN };

constexpr size_t MiB = 1u << 20;
constexpr size_t WS_CTL = 0, CTL_ZERO_BYTES = 1 * MiB;
constexpr size_t WS_MOD = 1 * MiB;
constexpr size_t WS_BON = 2 * MiB;
constexpr size_t WS_SMALL = 4 * MiB;
constexpr size_t SM_WUP = 0, SM_AUP = 524288, SM_GUP = 1048576, SM_WS = 1572864;
constexpr size_t WS_W16 = 8 * MiB;
constexpr size_t W_INR = 0, W_INUV = (size_t)3584 * 1024, W_ING = (size_t)5632 * 1024, W_A = (size_t)7680 * 1024, W_B = (size_t)8704 * 1024, W_OUT = (size_t)9728 * 1024,
                 W_1 = (size_t)10752 * 1024, W_2 = (size_t)14848 * 1024, W_END = (size_t)18944 * 1024;
constexpr size_t WS_B = 48 * MiB;
constexpr size_t WS_BIG = 96 * MiB;
constexpr size_t WS_END = 288 * MiB;
static_assert(WS_W16 + W_END * 2 <= WS_B && WS_BIG + (size_t)M * DFF * 2 <= WS_END && (size_t)M * ZRN * 2 <= 192 * MiB, "ws map");

constexpr int RING_BYTES = 131072;
constexpr int LDS_BYTES = 147456;

#define LAS __attribute__((address_space(3)))
typedef _Float16 f16;
typedef _Float16 f16x4 __attribute__((ext_vector_type(4)));
typedef _Float16 f16x8 __attribute__((ext_vector_type(8)));
typedef float f32x4 __attribute__((ext_vector_type(4)));
typedef unsigned u32x2 __attribute__((ext_vector_type(2)));
typedef unsigned u32x4 __attribute__((ext_vector_type(4)));
typedef short v4i16_t __attribute__((ext_vector_type(4)));
using pg8::pk_f16; using pg8::f16lo; using pg8::f16hi; using pg8::fast_sigmoid;

struct Args { const float* in[N_IN]; float* out; unsigned char* ws; int ph_lo, ph_hi; };
static_assert(sizeof(Args) == N_IN * 8 + 8 + 8 + 8, "Args has no padding");

__device__ __forceinline__ float wave_sum(float v) {
#pragma unroll
    for (int o = 1; o < 64; o <<= 1) v += __shfl_xor(v, o);
    return v;
}
#define LDS_WAIT() asm volatile("s_waitcnt lgkmcnt(0)" ::: "memory")

__device__ __forceinline__ void transpose_item(const float* W, int K, int N, f16* WT, int split, int split_add, LAS float* scr, int item, int lane) {
    const int nblk = N / 32, kb = item / nblk, nb = item % nblk, k0 = 64 * kb, n0 = 32 * nb;
#pragma unroll 8
    for (int i = 0; i < 32; ++i) { const int kk = 2 * i + (lane >> 5); scr[kk * 33 + (lane & 31)] = W[(size_t)(k0 + kk) * N + n0 + (lane & 31)]; }
    LDS_WAIT(); asm volatile("" ::: "memory");
    const int c = lane & 7;
    const int radd = (n0 >= split) ? split_add : 0;
#pragma unroll
    for (int j = 0; j < 4; ++j) { const int n = (lane >> 3) + 8 * j; const LAS float* s = scr + (8 * c) * 33 + n;
        u32x4 o; o.x = pk_f16(s[0 * 33], s[1 * 33]); o.y = pk_f16(s[2 * 33], s[3 * 33]); o.z = pk_f16(s[4 * 33], s[5 * 33]); o.w = pk_f16(s[6 * 33], s[7 * 33]);
        *(u32x4*)(WT + (size_t)(radd + n0 + n) * K + k0 + 8 * c) = o; }
    LDS_WAIT(); asm volatile("" ::: "memory");
}
__device__ __forceinline__ void convert_layer_weights(const Args& a, int z, int l, LAS unsigned char* lds, int gw, int ngw, int wave, int lane, int gtid, int ngt) {
    LAS float* scr = (LAS float*)(lds + wave * 16384);
    f16* W16 = (f16*)(a.ws + WS_W16);
    constexpr int I_IN = 16 * (DIN / 32), I_SQ = 16 * 32, I_1 = 16 * (DFF / 32), I_2 = (DFF / 64) * 32;
    constexpr int NITEMS = I_IN + 3 * I_SQ + I_1 + I_2;
    for (int it = gw; it < NITEMS; it += ngw) {
        int r = it;
        if (r < I_IN) { transpose_item(a.in[z + I_WIN] + (size_t)l * D * DIN, D, DIN, W16 + W_INR, CRW, 128, scr, r, lane); continue; } r -= I_IN;
        if (r < I_SQ) { transpose_item(a.in[z + I_WBA] + (size_t)l * D * D, D, D, W16 + W_A, 1 << 30, 0, scr, r, lane); continue; } r -= I_SQ;
        if (r < I_SQ) { transpose_item(a.in[z + I_WBB] + (size_t)l * D * D, D, D, W16 + W_B, 1 << 30, 0, scr, r, lane); continue; } r -= I_SQ;
        if (r < I_SQ) { transpose_item(a.in[z + I_WOUT] + (size_t)l * D * D, D, D, W16 + W_OUT, 1 << 30, 0, scr, r, lane); continue; } r -= I_SQ;
        if (r < I_1) { transpose_item(a.in[z + I_W1] + (size_t)l * D * DFF, D, DFF, W16 + W_1, 1 << 30, 0, scr, r, lane); continue; } r -= I_1;
        transpose_item(a.in[z + I_W2] + (size_t)l * DFF * D, DFF, D, W16 + W_2, 1 << 30, 0, scr, r, lane);
    }
    u32x4* pad = (u32x4*)(W16 + W_INR + (size_t)CRW * 1024);
    for (int i = gtid; i < 128 * 1024 / 8; i += ngt) pad[i] = (u32x4){0u, 0u, 0u, 0u};
}
__device__ __forceinline__ void p0_prologue(const Args& a, int z, LAS unsigned char* lds, int G, int bx, int tid, int wave, int lane) {
    const int gw = bx * NWAVES + wave, ngw = G * NWAVES, gtid = bx * NTHR + tid, ngt = G * NTHR;
    {
        LAS float* SC = (LAS float*)lds;
        LAS float* P = (LAS float*)(lds + 20480);
        float* MOD = (float*)(a.ws + WS_MOD);
        bool have_sc = false;
        for (int item = bx; item < NLAYER * 96; item += G) {
            if (!have_sc) {
                for (int i = tid; i < 5 * 1024; i += NTHR) { const float x = (i < 1024) ? a.in[z + I_CCTX][i] : a.in[z + I_C][i - 1024]; SC[i] = x * fast_sigmoid(x); }
                have_sc = true;
            }
            __syncthreads();
            const int l = item / 96, n0 = (item % 96) * 64;
            const float* wp = a.in[z + I_WADA] + ((size_t)l * 1024 + wave * 128) * 6144 + n0 + lane;
            float acc[5] = {0.f, 0.f, 0.f, 0.f, 0.f};
#pragma unroll 8
            for (int kk = 0; kk < 128; ++kk) { const float wv = wp[(size_t)kk * 6144]; const int k = wave * 128 + kk;
#pragma unroll
                for (int s = 0; s < 5; ++s) acc[s] += SC[s * 1024 + k] * wv; }
#pragma unroll
            for (int s = 0; s < 5; ++s) P[(wave * 5 + s) * 64 + lane] = acc[s];
            __syncthreads();
            if (tid < 320) { const int s = tid >> 6, ln = tid & 63; float v = a.in[z + I_BADA][l * 6144 + n0 + ln];
#pragma unroll
                for (int w = 0; w < 8; ++w) v += P[(w * 5 + s) * 64 + ln];
                MOD[((size_t)l * 5 + s) * 6144 + n0 + ln] = v; }
        }
        __syncthreads();
    }
    {
        LAS float* scr = (LAS float*)(lds + wave * 16384);
        unsigned char* sm = a.ws + WS_SMALL;
        for (int it = gw; it < 128 + 128 + 128; it += ngw) {
            if (it < 128) { const int ld = it >> 5; transpose_item(a.in[z + I_WUP] + (size_t)ld * 64 * 1024, 64, 1024, (f16*)(sm + SM_WUP) + (size_t)ld * 1024 * 64, 1 << 30, 0, scr, it & 31, lane); }
            else if (it < 256) { const int ld = (it - 128) >> 5; transpose_item(a.in[z + I_AUP] + (size_t)ld * 64 * 1024, 64, 1024, (f16*)(sm + SM_AUP) + (size_t)ld * 1024 * 64, 1 << 30, 0, scr, it & 31, lane); }
            else { const int l = (it - 256) >> 6; transpose_item(a.in[z + I_GUP] + (size_t)l * 128 * 1024, 128, 1024, (f16*)(sm + SM_GUP) + (size_t)l * 1024 * 128, 1 << 30, 0, scr, it & 63, lane); }
        }
        f16* ws16 = (f16*)(sm + SM_WS); const float* wsrc = a.in[z + I_WS];
        for (int i = gtid; i < NLAYER * 8 * 128 * 128 / 4; i += ngt) { const f32x4 v = *(const f32x4*)(wsrc + (size_t)i * 4); u32x2 o; o.x = pk_f16(v[0], v[1]); o.y = pk_f16(v[2], v[3]); *(u32x2*)(ws16 + (size_t)i * 4) = o; }
    }
    convert_layer_weights(a, z, 0, lds, gw, ngw, wave, lane, gtid, ngt);
}

__device__ __forceinline__ const float* xrow_ptr(const float* base_ctx, const float* base_lat, int row) { return row < MCTX ? base_ctx + (size_t)row * D : base_lat + (size_t)(row - MCTX) * D; }
__device__ __forceinline__ int row_stream(int row) { return row < MCTX ? 0 : 1 + ((row - MCTX) >> 12); }
__device__ __forceinline__ void norm_phase(const float* base_ctx, const float* base_lat, const float* gain, const float* modl, int sh_idx, int sc_idx, f16* H, int gw, int ngw, int lane) {
    const int rpw = (M + ngw - 1) / ngw; const int r0 = gw * rpw, r1 = (r0 + rpw < M) ? r0 + rpw : M;
    int cur_s = -1; f32x4 gm[4], sh[4];
    for (int row = r0; row < r1; ++row) {
        const int s = row_stream(row);
        if (s != cur_s) { cur_s = s;
#pragma unroll
            for (int j = 0; j < 4; ++j) { const int c = 4 * lane + 256 * j; const f32x4 g = *(const f32x4*)(gain + c); const f32x4 sc = *(const f32x4*)(modl + (size_t)s * 6144 + sc_idx * 1024 + c);
                gm[j] = g * (sc + 1.0f); sh[j] = *(const f32x4*)(modl + (size_t)s * 6144 + sh_idx * 1024 + c); } }
        const f32x4* xr = (const f32x4*)xrow_ptr(base_ctx, base_lat, row) + lane;
        f32x4 v[4]; float ss = 0.f;
#pragma unroll
        for (int j = 0; j < 4; ++j) { v[j] = xr[64 * j]; ss += (v[j][0] * v[j][0] + v[j][1] * v[j][1]) + (v[j][2] * v[j][2] + v[j][3] * v[j][3]); }
        const float rs = __builtin_amdgcn_rsqf(wave_sum(ss) * (1.0f / D) + EPS);
        u32x2* o = (u32x2*)(H + (size_t)row * D) + lane;
#pragma unroll
        for (int j = 0; j < 4; ++j) { const f32x4 y = v[j] * rs * gm[j] + sh[j]; u32x2 w; w.x = pk_f16(y[0], y[1]); w.y = pk_f16(y[2], y[3]); o[64 * j] = w; }
    }
}
__device__ __forceinline__ void final_norm_phase(float* X, const float* gain, int gw, int ngw, int lane) {
    f32x4 g[4];
#pragma unroll
    for (int j = 0; j < 4; ++j) g[j] = *(const f32x4*)(gain + 4 * lane + 256 * j);
    for (int row = gw; row < M; row += ngw) {
        f32x4* xr = (f32x4*)(X + (size_t)row * D) + lane;
        f32x4 v[4]; float ss = 0.f;
#pragma unroll
        for (int j = 0; j < 4; ++j) { v[j] = xr[64 * j]; ss += (v[j][0] * v[j][0] + v[j][1] * v[j][1]) + (v[j][2] * v[j][2] + v[j][3] * v[j][3]); }
        const float rs = __builtin_amdgcn_rsqf(wave_sum(ss) * (1.0f / D) + EPS);
#pragma unroll
        for (int j = 0; j < 4; ++j) xr[64 * j] = v[j] * rs * g[j];
    }
}

constexpr int SC_R = 0, SC_W = 4096, SC_KD = 8192, SC_V = 12288, SC_NKK = 16384, SC_BB = 20480, SC_KRAW = 24576, SC_ASG = 28672, SC_G = 32768, SC_Y = 36864,
              SC_WD = 40960, SC_AD = 43264, SC_GD = 45568, SC_BON = 49920, SC_DIR = 50176;
constexpr int LORA_LD = 72, GD_LD = 136;
static_assert(2 * SC_DIR <= LDS_BYTES, "scan LDS");

__device__ __forceinline__ f32x4 ld4h(const f16* p) { const u32x2 w = *(const u32x2*)p; return (f32x4){f16lo(w.x), f16hi(w.x), f16lo(w.y), f16hi(w.y)}; }
template <bool LAT> __device__ __forceinline__ f32x4 shift_mix(const f16* Zr, size_t row, int t, int T, int c0, const float* mu) {
    const f16* p = Zr + row * ZRN + c0;
    const f32x4 z = ld4h(p); const f32x4 zero = {0.f, 0.f, 0.f, 0.f};
    f32x4 nb;
    if (LAT) {
        const int col = t & 63, rw = t >> 6;
        const f32x4 le = col >= 1 ? ld4h(p - ZRN) : zero, ri = col < 63 ? ld4h(p + ZRN) : zero, up = rw >= 1 ? ld4h(p - 64 * ZRN) : zero, dn = rw < 63 ? ld4h(p + 64 * ZRN) : zero;
        nb = (f32x4){le[0], ri[1], up[2], dn[3]};
    } else {
        const f32x4 pv = t >= 1 ? ld4h(p - ZRN) : zero, nx = (t + 1 < T) ? ld4h(p + ZRN) : zero;
        nb = (f32x4){pv[0], nx[1], pv[2], nx[3]};
    }
    const f32x4 m = *(const f32x4*)(mu + c0);
    return z + m * (nb - z);
}
__device__ __forceinline__ float fast_tanh(float x) { return 1.0f - 2.0f * __builtin_amdgcn_rcpf(1.0f + __expf(2.0f * x)); }

template <bool LAT, bool FIN> __device__ __forceinline__ void scan_load(LAS unsigned char* lds, const f16* Zr, const float* mu, size_t row_base, int T, int h, int tile_f, int tile_b, int tid) {
    constexpr int NG = FIN ? 112 : 80;
    for (int it = tid; it < 2 * 16 * NG; it += NTHR) {
        const int d = it / (16 * NG), rem = it % (16 * NG), tok = rem / NG, g = rem % NG;
        const int t = (d ? tile_b : tile_f) * 16 + tok;
        LAS unsigned char* L = lds + d * SC_DIR;
        int c0, kind, gg;
        if (g < 16) { kind = 0; gg = g; c0 = h * 64 + 4 * gg; }
        else if (g < 32) { kind = 1; gg = g - 16; c0 = 1024 + h * 64 + 4 * gg; }
        else if (g < 48) { kind = 2; gg = g - 32; c0 = 2048 + h * 64 + 4 * gg; }
        else if (g < 64) { kind = 3; gg = g - 48; c0 = 3072 + d * 64 + 4 * gg; }
        else if (g < 80) { kind = 4; gg = g - 64; c0 = 3200 + d * 64 + 4 * gg; }
        else { kind = 5; gg = g - 80; c0 = 3328 + 4 * gg; }
        const f32x4 z = shift_mix<LAT>(Zr, row_base + t, t, T, c0, mu);
        if (kind == 0) *(LAS f32x4*)(L + SC_R + (tok * 64 + 4 * gg) * 4) = z;
        else if (kind == 1) *(LAS f32x4*)(L + SC_KRAW + (tok * 64 + 4 * gg) * 4) = z;
        else if (kind == 2) *(LAS f32x4*)(L + SC_V + (tok * 64 + 4 * gg) * 4) = z;
        else if (kind == 3) { u32x2 w; w.x = pk_f16(fast_tanh(z[0]), fast_tanh(z[1])); w.y = pk_f16(fast_tanh(z[2]), fast_tanh(z[3])); *(LAS u32x2*)(L + SC_WD + (tok * LORA_LD + 4 * gg) * 2) = w; }
        else if (kind == 4) { u32x2 w; w.x = pk_f16(z[0], z[1]); w.y = pk_f16(z[2], z[3]); *(LAS u32x2*)(L + SC_AD + (tok * LORA_LD + 4 * gg) * 2) = w; }
        else { u32x2 w; w.x = pk_f16(fast_sigmoid(z[0]), fast_sigmoid(z[1])); w.y = pk_f16(fast_sigmoid(z[2]), fast_sigmoid(z[3])); *(LAS u32x2*)(L + SC_GD + (tok * GD_LD + 4 * gg) * 2) = w; }
    }
}

#define FMAC_BC(acc, x, s, N) asm("v_fmac_f32_dpp %0, %1, %2 row_newbcast:" #N " row_mask:0xf bank_mask:0xf" : "+v"(acc) : "v"(x), "v"(s))
#define MUL_BC(dst, x, s, N) asm("v_mul_f32_dpp %0, %1, %2 row_newbcast:" #N " row_mask:0xf bank_mask:0xf" : "=v"(dst) : "v"(x), "v"(s))
#define SA_STEP(n, accv) FMAC_BC(accv, xa, S[n], n);
#define UPD_STEP(n, accv) { float t_; MUL_BC(t_, xk, xv, n); FMAC_BC(t_, xb, sa, n); FMAC_BC(t_, xw, S[n], n); S[n] = t_; FMAC_BC(accv, xr, t_, n); }

template <bool LAT> __device__ __forceinline__ void scan_unit(const Args& a, int z, int l, LAS unsigned char* lds, int b, int h, int tid, int wave, int lane) {
    constexpr int T = LAT ? TLAT : TCTX, NT = T / 16;
    const size_t row_base = LAT ? (size_t)MCTX + (size_t)b * TLAT : (size_t)b * TCTX;
    const f16* Zr = (const f16*)(a.ws + WS_BIG);
    f16* YA = (f16*)(a.ws + WS_B);
    float* BONG = (float*)(a.ws + WS_BON);
    const float* mu = a.in[z + I_MU] + (size_t)l * CRW;
    const int d = wave >> 2, rg = wave & 3, ct = wave & 3;
    const int hj = h * 64 + lane;
    const unsigned char* sm = a.ws + WS_SMALL;
    const int lcol = h * 64 + ct * 16 + (lane & 15), kq = 8 * (lane >> 4);
    f16x8 wupB[2], aupB[2], gupB[4];
    {
        const f16* wu = (const f16*)(sm + SM_WUP) + ((size_t)(l * 2 + d) * 1024 + lcol) * 64 + kq;
        const f16* au = (const f16*)(sm + SM_AUP) + ((size_t)(l * 2 + d) * 1024 + lcol) * 64 + kq;
        const f16* gu = (const f16*)(sm + SM_GUP) + ((size_t)l * 1024 + lcol) * 128 + kq;
#pragma unroll
        for (int ks = 0; ks < 2; ++ks) { wupB[ks] = *(const f16x8*)(wu + 32 * ks); aupB[ks] = *(const f16x8*)(au + 32 * ks); }
#pragma unroll
        for (int ks = 0; ks < 4; ++ks) gupB[ks] = *(const f16x8*)(gu + 32 * ks);
    }
    const float w0v = a.in[z + I_W0][(size_t)(l * 2 + d) * 1024 + lcol], a0v = a.in[z + I_A0][(size_t)(l * 2 + d) * 1024 + lcol];
    const float kkc = a.in[z + I_KK][l * 1024 + hj], kac = a.in[z + I_KA][l * 1024 + hj], rkc = a.in[z + I_RK][l * 1024 + hj];
    const float lng = a.in[z + I_LNXG][l * 1024 + hj], lnb = a.in[z + I_LNXB][l * 1024 + hj];
    float S[16];
    const size_t sidx = ((((size_t)b * 2 + l) * 2 + d) * 16 + h) * 4096 + (size_t)(16 * rg + (lane & 15)) * 64 + 16 * (lane >> 4);
    if (LAT) { const float* sp = a.in[z + I_STATE] + sidx;
#pragma unroll
        for (int q = 0; q < 4; ++q) { const f32x4 v = *(const f32x4*)(sp + 4 * q); S[4 * q] = v[0]; S[4 * q + 1] = v[1]; S[4 * q + 2] = v[2]; S[4 * q + 3] = v[3]; } }
    else {
#pragma unroll
        for (int n = 0; n < 16; ++n) S[n] = 0.f; }
    LAS unsigned char* Ld = lds + d * SC_DIR;
    const int sh16 = ((lane ^ 16) << 2), sh32 = ((lane ^ 32) << 2);

    for (int n = 0; n < NT; ++n) {
        const bool fin = (n >= NT / 2);
        const int tile_f = n, tile_b = NT - 1 - n;
        if (fin) scan_load<LAT, true>(lds, Zr, mu, row_base, T, h, tile_f, tile_b, tid);
        else scan_load<LAT, false>(lds, Zr, mu, row_base, T, h, tile_f, tile_b, tid);
        __syncthreads();
        {
            f32x4 cw = {0.f, 0.f, 0.f, 0.f}, ca = {0.f, 0.f, 0.f, 0.f};
#pragma unroll
            for (int ks = 0; ks < 2; ++ks) {
                const f16x8 fw = *(const LAS f16x8*)(Ld + SC_WD + ((lane & 15) * LORA_LD + kq + 32 * ks) * 2);
                const f16x8 fa = *(const LAS f16x8*)(Ld + SC_AD + ((lane & 15) * LORA_LD + kq + 32 * ks) * 2);
                cw = __builtin_amdgcn_mfma_f32_16x16x32_f16(fw, wupB[ks], cw, 0, 0, 0);
                ca = __builtin_amdgcn_mfma_f32_16x16x32_f16(fa, aupB[ks], ca, 0, 0, 0);
            }
            const int jc = ct * 16 + (lane & 15);
#pragma unroll
            for (int r = 0; r < 4; ++r) { const int tok = 4 * (lane >> 4) + r;
                *(LAS float*)(Ld + SC_W + (tok * 64 + jc) * 4) = __expf(-DECAY_SCALE * fast_sigmoid(w0v + cw[r]));
                *(LAS float*)(Ld + SC_ASG + (tok * 64 + jc) * 4) = fast_sigmoid(a0v + ca[r]); }
            if (fin) {
                f32x4 cg_ = {0.f, 0.f, 0.f, 0.f};
#pragma unroll
                for (int ks = 0; ks < 4; ++ks) { const f16x8 fg = *(const LAS f16x8*)(Ld + SC_GD + ((lane & 15) * GD_LD + kq + 32 * ks) * 2); cg_ = __builtin_amdgcn_mfma_f32_16x16x32_f16(fg, gupB[ks], cg_, 0, 0, 0); }
#pragma unroll
                for (int r = 0; r < 4; ++r) *(LAS float*)(Ld + SC_G + ((4 * (lane >> 4) + r) * 64 + jc) * 4) = cg_[r];
            }
        }
        __syncthreads();
#pragma unroll
        for (int q = 0; q < 4; ++q) { const int p = wave * 4 + q, dd = p >> 4, tok = p & 15; LAS unsigned char* L = lds + dd * SC_DIR; const int o = (tok * 64 + lane) * 4;
            const float kraw = *(LAS float*)(L + SC_KRAW + o), asg = *(LAS float*)(L + SC_ASG + o), rr = *(LAS float*)(L + SC_R + o);
            const float kkv = kraw * kkc; const float ss = wave_sum(kkv * kkv); const float kkn = kkv * __builtin_amdgcn_rsqf(ss + 1e-12f);
            const float kd = kraw * (1.0f + (asg - 1.0f) * kac);
            *(LAS float*)(L + SC_NKK + o) = -kkn; *(LAS float*)(L + SC_BB + o) = asg * kkn; *(LAS float*)(L + SC_KD + o) = kd;
            const float bon = wave_sum(kd * rkc * rr);
            if (lane == 0) *(LAS float*)(L + SC_BON + tok * 4) = bon; }
        __syncthreads();
#pragma unroll 4
        for (int tt = 0; tt < 16; ++tt) { const int tok = d ? 15 - tt : tt; const int o = (tok * 64 + lane) * 4;
            const float xa = *(LAS float*)(Ld + SC_NKK + o), xw = *(LAS float*)(Ld + SC_W + o), xb = *(LAS float*)(Ld + SC_BB + o), xk = *(LAS float*)(Ld + SC_KD + o), xr = *(LAS float*)(Ld + SC_R + o);
            const float xv = *(LAS float*)(Ld + SC_V + (tok * 64 + 16 * rg + (lane & 15)) * 4);
            float sa0 = 0.f, sa1 = 0.f;
            SA_STEP(0, sa0) SA_STEP(1, sa1) SA_STEP(2, sa0) SA_STEP(3, sa1) SA_STEP(4, sa0) SA_STEP(5, sa1) SA_STEP(6, sa0) SA_STEP(7, sa1)
            SA_STEP(8, sa0) SA_STEP(9, sa1) SA_STEP(10, sa0) SA_STEP(11, sa1) SA_STEP(12, sa0) SA_STEP(13, sa1) SA_STEP(14, sa0) SA_STEP(15, sa1)
            float sa = sa0 + sa1;
            sa += __builtin_bit_cast(float, __builtin_amdgcn_ds_bpermute(sh16, __builtin_bit_cast(int, sa)));
            sa += __builtin_bit_cast(float, __builtin_amdgcn_ds_bpermute(sh32, __builtin_bit_cast(int, sa)));
            float y0 = 0.f, y1 = 0.f;
            UPD_STEP(0, y0) UPD_STEP(1, y1) UPD_STEP(2, y0) UPD_STEP(3, y1) UPD_STEP(4, y0) UPD_STEP(5, y1) UPD_STEP(6, y0) UPD_STEP(7, y1)
            UPD_STEP(8, y0) UPD_STEP(9, y1) UPD_STEP(10, y0) UPD_STEP(11, y1) UPD_STEP(12, y0) UPD_STEP(13, y1) UPD_STEP(14, y0) UPD_STEP(15, y1)
            float y = y0 + y1;
            y += __builtin_bit_cast(float, __builtin_amdgcn_ds_bpermute(sh16, __builtin_bit_cast(int, y)));
            y += __builtin_bit_cast(float, __builtin_amdgcn_ds_bpermute(sh32, __builtin_bit_cast(int, y)));
            if (lane < 16) *(LAS float*)(Ld + SC_Y + (tok * 64 + 16 * rg + lane) * 4) = y;
        }
        __syncthreads();
#pragma unroll
        for (int q = 0; q < 4; ++q) { const int p = wave * 4 + q, dd = p >> 4, tok = p & 15; LAS unsigned char* L = lds + dd * SC_DIR; const int o = (tok * 64 + lane) * 4;
            const size_t row = row_base + (size_t)((dd ? tile_b : tile_f) * 16 + tok);
            f16* yp = YA + row * D + hj;
            const float yv = *(LAS float*)(L + SC_Y + o);
            if (!fin) { *yp = (f16)yv; if (lane == 0) BONG[row * 16 + h] = *(LAS float*)(L + SC_BON + tok * 4); }
            else {
                const float y = yv + (float)(*yp);
                const float mean = wave_sum(y) * (1.0f / 64.0f); const float dv = y - mean; const float var = wave_sum(dv * dv) * (1.0f / 64.0f);
                const float yn = dv * __builtin_amdgcn_rsqf(var + GN_EPS) * lng + lnb;
                const float bon = *(LAS float*)(L + SC_BON + tok * 4) + BONG[row * 16 + h];
                const float vv = *(LAS float*)(L + SC_V + o), gg = *(LAS float*)(L + SC_G + o);
                *yp = (f16)((yn + bon * vv) * gg);
            } }
        __syncthreads();
    }
    if (!LAT) { float* sp = a.out + (size_t)M * D + sidx;
#pragma unroll
        for (int q = 0; q < 4; ++q) *(f32x4*)(sp + 4 * q) = (f32x4){S[4 * q], S[4 * q + 1], S[4 * q + 2], S[4 * q + 3]}; }
}
__device__ __forceinline__ void scan_phase(const Args& a, int z, int l, LAS unsigned char* lds, int G, int bx, int tid, int wave, int lane) {
    if (G == 256) {
        if (bx < 64) scan_unit<true>(a, z, l, lds, bx >> 4, bx & 15, tid, wave, lane);
        else for (int u = bx - 64; u < 512; u += 192) scan_unit<false>(a, z, l, lds, u >> 4, u & 15, tid, wave, lane);
    } else {
        for (int u = bx; u < 576; u += G) { if (u < 64) scan_unit<true>(a, z, l, lds, u >> 4, u & 15, tid, wave, lane); else scan_unit<false>(a, z, l, lds, (u - 64) >> 4, (u - 64) & 15, tid, wave, lane); }
    }
}

constexpr int MX_T = 0, MX_LD = 272, MX_STAT = 128 * MX_LD;
__device__ __forceinline__ f16x4 tr_read(LAS unsigned char* p) { return __builtin_bit_cast(f16x4, __builtin_amdgcn_ds_read_tr16_b64_v4i16((LAS v4i16_t*)p)); }
__device__ __forceinline__ void mix_phase(const Args& a, int z, int l, LAS unsigned char* lds, int G, int bx, int tid, int wave, int lane) {
    f16* U16 = (f16*)(a.ws + WS_BIG + 48 * MiB); const f16* V16 = (const f16*)(a.ws + WS_BIG + 96 * MiB);
    const f16* ws16 = (const f16*)(a.ws + WS_SMALL + SM_WS) + (size_t)l * 8 * 128 * 128;
    const float* lnvg = a.in[z + I_LNVG] + l * 1024; const float* bs = a.in[z + I_BS] + l * 1024;
    LAS float* STAT = (LAS float*)(lds + MX_STAT);
    for (int unit = bx; unit < M / 128; unit += G) {
        const size_t r0 = (size_t)unit * 128;
        for (int rr = 0; rr < 16; ++rr) { const int q = 16 * wave + rr; const f16* p = V16 + (r0 + q) * D + 8 * lane;
            const f16x8 x0 = *(const f16x8*)p, x1 = *(const f16x8*)(p + 512);
            float s = 0.f;
#pragma unroll
            for (int e = 0; e < 8; ++e) s += (float)x0[e] + (float)x1[e];
            const float mean = wave_sum(s) * (1.0f / D); float s2 = 0.f;
#pragma unroll
            for (int e = 0; e < 8; ++e) { const float d0 = (float)x0[e] - mean, d1 = (float)x1[e] - mean; s2 += d0 * d0 + d1 * d1; }
            const float rstd = __builtin_amdgcn_rsqf(wave_sum(s2) * (1.0f / D) + EPS);
            if (lane == 0) { STAT[2 * q] = mean; STAT[2 * q + 1] = rstd; } }
        __syncthreads();
        for (int h = 0; h < 8; ++h) {
#pragma unroll
            for (int i = 0; i < 4; ++i) { const int item = tid + NTHR * i, q = item >> 4, ch = item & 15;
                const f16x8 x = *(const f16x8*)(V16 + (r0 + q) * D + h * 128 + 8 * ch);
                const f32x4 g0 = *(const f32x4*)(lnvg + h * 128 + 8 * ch), g1 = *(const f32x4*)(lnvg + h * 128 + 8 * ch + 4);
                const float mean = STAT[2 * q], rstd = STAT[2 * q + 1];
                u32x4 w; w.x = pk_f16(((float)x[0] - mean) * rstd * g0[0], ((float)x[1] - mean) * rstd * g0[1]); w.y = pk_f16(((float)x[2] - mean) * rstd * g0[2], ((float)x[3] - mean) * rstd * g0[3]);
                w.z = pk_f16(((float)x[4] - mean) * rstd * g1[0], ((float)x[5] - mean) * rstd * g1[1]); w.w = pk_f16(((float)x[6] - mean) * rstd * g1[2], ((float)x[7] - mean) * rstd * g1[3]);
                *(LAS u32x4*)(lds + MX_T + q * MX_LD + ch * 16) = w; }
            __syncthreads();
            const int pl = 16 * wave + (lane & 15);
            f16x8 wfrag[4];
#pragma unroll
            for (int ks = 0; ks < 4; ++ks) wfrag[ks] = *(const f16x8*)(ws16 + ((size_t)(h * 128 + pl)) * 128 + 32 * ks + 8 * (lane >> 4));
            const float bsv = bs[h * 128 + pl];
            LAS unsigned char* tb = lds + MX_T + (8 * (lane >> 4) + ((lane & 15) >> 2)) * MX_LD + (4 * (lane & 3)) * 2;
#pragma unroll
            for (int ct = 0; ct < 8; ++ct) {
                f32x4 acc = {0.f, 0.f, 0.f, 0.f};
#pragma unroll
                for (int ks = 0; ks < 4; ++ks) {
                    const f16x4 v1 = tr_read(tb + (32 * ks) * MX_LD + ct * 32), v2 = tr_read(tb + (32 * ks + 4) * MX_LD + ct * 32);
                    const f16x8 vf = {v1[0], v1[1], v1[2], v1[3], v2[0], v2[1], v2[2], v2[3]};
                    acc = __builtin_amdgcn_mfma_f32_16x16x32_f16(vf, wfrag[ks], acc, 0, 0, 0);
                }
                f16* up = U16 + (r0 + pl) * D + h * 128 + 16 * ct + 4 * (lane >> 4);
                const u32x2 uu = *(const u32x2*)up;
                u32x2 o; o.x = pk_f16(f16lo(uu.x) * (acc[0] + bsv), f16hi(uu.x) * (acc[1] + bsv)); o.y = pk_f16(f16lo(uu.y) * (acc[2] + bsv), f16hi(uu.y) * (acc[3] + bsv));
                *(u32x2*)up = o;
            }
            __syncthreads();
        }
    }
}

constexpr int PH_PER_LAYER = 13, NPHASES = 1 + NLAYER * PH_PER_LAYER + 1;
template <int ph> __device__ __forceinline__ void run_phase(const Args& a, LAS unsigned char* lds) {
    int tid = threadIdx.x; asm volatile("" : "+v"(tid));
    int bx = blockIdx.x; asm volatile("" : "+s"(bx));
    int G = gridDim.x; asm volatile("" : "+s"(G));
    int z = 0; asm volatile("" : "+s"(z));
    const int lane = tid & 63, wave = __builtin_amdgcn_readfirstlane(tid >> 6);
    const int gw = bx * NWAVES + wave, ngw = G * NWAVES;
    unsigned char* ws = a.ws;
    f16* W16 = (f16*)(ws + WS_W16);
    f16* RB = (f16*)(ws + WS_B);
    f16* BIG = (f16*)(ws + WS_BIG);
    f16* HB2 = BIG;
    f16* U16 = (f16*)(ws + WS_BIG + 48 * MiB);
    f16* G16 = (f16*)(ws + WS_BIG + 96 * MiB);
    float* X = a.out;
    const float* MOD = (const float*)(ws + WS_MOD);
    if (ph == 0) { p0_prologue(a, z, lds, G, bx, tid, wave, lane); }
    else if (ph == NPHASES - 1) { final_norm_phase(X, a.in[z + I_FING], gw, ngw, lane); }
    else {
        constexpr int l = (ph - 1) / PH_PER_LAYER, k = (ph - 1) % PH_PER_LAYER;
        const float* modl = MOD + (size_t)l * 5 * 6144;
        constexpr bool x_in_out = (l > 0);
        const float* bc = x_in_out ? (const float*)X : a.in[z + I_XP];
        const float* bl = x_in_out ? (const float*)(X + (size_t)MCTX * D) : a.in[z + I_XS];
        if constexpr (k == 0) {
            if (l > 0) convert_layer_weights(a, z, l, lds, gw, ngw, wave, lane, bx * NTHR + tid, G * NTHR);
            norm_phase(bc, bl, a.in[z + I_N1G] + l * D, modl, 0, 1, RB, gw, ngw, lane);
        } else if constexpr (k == 1) { pg8::Gemm g{RB, W16 + W_INR, M, ZRN, D}; pg8::StaticOrder S; S.init(M, ZRN, G, bx); pg8::EpiH16<0> E{BIG, ZRN, 0, 0};
            pg8::gemm_phase<pg8::EpiH16<0>, pg8::StaticOrder, true, true>(lds, g, S, E);
        } else if constexpr (k == 2) { scan_phase(a, z, l, lds, G, bx, tid, wave, lane);
        } else if constexpr (k == 3) { norm_phase(bc, bl, a.in[z + I_N1G] + l * D, modl, 0, 1, HB2, gw, ngw, lane);
        } else if constexpr (k == 4) { pg8::Gemm g{HB2, W16 + W_INUV, M, 2048, D}; pg8::StaticOrder S; S.init(M, 2048, G, bx); pg8::EpiH16<1> E{U16, D, 1024, (size_t)(48 * MiB / 2)};
            pg8::gemm_phase<pg8::EpiH16<1>, pg8::StaticOrder, true, true>(lds, g, S, E);
        } else if constexpr (k == 5) { mix_phase(a, z, l, lds, G, bx, tid, wave, lane);
        } else if constexpr (k == 6) { pg8::Gemm g{HB2, W16 + W_ING, M, 2048, D}; pg8::StaticOrder S; S.init(M, 2048, G, bx); pg8::EpiH16<2> E{G16, 2048, 0, 0};
            pg8::gemm_phase<pg8::EpiH16<2>, pg8::StaticOrder, true, true>(lds, g, S, E);
        } else if constexpr (k == 7) { pg8::Gemm g{RB, W16 + W_A, M, D, D}; pg8::StaticOrder S; S.init(M, D, G, bx); pg8::EpiMix<false> E{HB2, G16, 0};
            pg8::gemm_phase<pg8::EpiMix<false>, pg8::StaticOrder, true, true>(lds, g, S, E);
        } else if constexpr (k == 8) { pg8::Gemm g{U16, W16 + W_B, M, D, D}; pg8::StaticOrder S; S.init(M, D, G, bx); pg8::EpiMix<true> E{HB2, G16, 1024};
            pg8::gemm_phase<pg8::EpiMix<true>, pg8::StaticOrder, true, true>(lds, g, S, E);
        } else if constexpr (k == 9) { pg8::Gemm g{HB2, W16 + W_OUT, M, D, D}; pg8::StaticOrder S; S.init(M, D, G, bx); pg8::EpiRes E{bc, bl, X, modl + 2 * 1024};
            pg8::gemm_phase<pg8::EpiRes, pg8::StaticOrder, true, true>(lds, g, S, E);
        } else if constexpr (k == 10) { norm_phase(X, X + (size_t)MCTX * D, a.in[z + I_N2G] + l * D, modl, 3, 4, RB, gw, ngw, lane);
        } else if constexpr (k == 11) { pg8::Gemm g{RB, W16 + W_1, M, DFF, D}; pg8::StaticOrder S; S.init(M, DFF, G, bx); pg8::EpiH16<3> E{BIG, DFF, 0, 0};
            pg8::gemm_phase<pg8::EpiH16<3>, pg8::StaticOrder, true, true>(lds, g, S, E);
        } else { pg8::Gemm g{BIG, W16 + W_2, M, D, DFF}; pg8::StaticOrder S; S.init(M, D, G, bx); pg8::EpiRes E{X, X + (size_t)MCTX * D, X, modl + 5 * 1024};
            pg8::gemm_phase<pg8::EpiRes, pg8::StaticOrder, true, true>(lds, g, S, E);
        }
    }
}
template <int ph> __device__ __forceinline__ void run_phases(const Args& a, LAS unsigned char* lds, cg::grid_group& grid) {
    if constexpr (ph < NPHASES) {
        if (a.ph_lo <= ph && ph < a.ph_hi) { run_phase<ph>(a, lds); if (ph + 1 < a.ph_hi) grid.sync(); }
        run_phases<ph + 1>(a, lds, grid);
    }
}
__global__ void __launch_bounds__(NTHR, 2) fwd_kernel(Args a) {
    extern __shared__ __attribute__((aligned(16))) unsigned char lds_raw[];
    LAS unsigned char* lds = (LAS unsigned char*)lds_raw;
    cg::grid_group grid = cg::this_grid();
    run_phases<0>(a, lds, grid);
}

extern "C" void kernel_launch(void* const* d_in, const int* in_sizes, int n_in, void* d_out, int out_size, void* d_ws, size_t ws_size, hipStream_t stream) {
    static int grid = 0;
    if (grid == 0) {
        if (n_in != N_IN || ws_size < WS_END) { fprintf(stderr, "kernel_launch: n_in %d (want %d), ws %zu (want >= %zu): nothing launched\n", n_in, (int)N_IN, ws_size, (size_t)WS_END); grid = -1; return; }
        int dev = 0, cus = 0, per_cu = 0;
        if (hipGetDevice(&dev) != hipSuccess || hipDeviceGetAttribute(&cus, hipDeviceAttributeMultiprocessorCount, dev) != hipSuccess) { grid = -1; return; }
        if (hipFuncSetAttribute((const void*)fwd_kernel, hipFuncAttributeMaxDynamicSharedMemorySize, LDS_BYTES) != hipSuccess) { fprintf(stderr, "kernel_launch: hipFuncSetAttribute failed\n"); grid = -1; return; }
        if (hipOccupancyMaxActiveBlocksPerMultiprocessor(&per_cu, (const void*)fwd_kernel, NTHR, LDS_BYTES) != hipSuccess || per_cu < 1) { fprintf(stderr, "kernel_launch: occupancy query says %d\n", per_cu); (void)hipGetLastError(); grid = -1; return; }
        grid = cus;
    }
    if (grid < 0) return;
    Args a{};
    for (int i = 0; i < N_IN; ++i) a.in[i] = (const float*)d_in[i];
    a.out = (float*)d_out; a.ws = (unsigned char*)d_ws;
#if MK_PER_PHASE
    for (int ph = 0; ph < NPHASES; ++ph) { a.ph_lo = ph; a.ph_hi = ph + 1; hipLaunchKernelGGL(fwd_kernel, dim3(grid), dim3(NTHR), LDS_BYTES, stream, a); }
#else
    a.ph_lo = 0; a.ph_hi = NPHASES;
    void* args[] = {&a};
    hipError_t e = hipLaunchCooperativeKernel((const void*)fwd_kernel, dim3(grid), dim3(NTHR), args, LDS_BYTES, stream);
    if (e != hipSuccess) fprintf(stderr, "kernel_launch: cooperative launch failed: %s (grid %d)\n", hipGetErrorString(e), grid);
#endif
}
```

```cpp
#include <hip/hip_runtime.h>
#include <hip/hip_cooperative_groups.h>
#include <cstdio>
#include <cstdint>
namespace cg = cooperative_groups;

#ifndef MK_PER_PHASE
#define MK_PER_PHASE 0
#endif

namespace pg8 {
#define PG8_LAS __attribute__((address_space(3)))
typedef _Float16 f16_t;
typedef _Float16 f16x8 __attribute__((ext_vector_type(8)));
typedef float f32x4 __attribute__((ext_vector_type(4)));
typedef unsigned u32x4 __attribute__((ext_vector_type(4)));
constexpr int BM = 256, BK = 64, HALF = 128, HTB = HALF * BK * 2  , STAGE_BYTES = 8 * HTB, NXCD = 8, WGM = 8;

__host__ __device__ __forceinline__ int lds_byte(int r, int c) { const int st = (r >> 4) * 2 + (c >> 5), rr = r & 15, cc = c & 31, ob = rr * 64 + cc * 2; return st * 1024 + (ob ^ (((ob >> 9) & 1) << 5)); }
__host__ __device__ __forceinline__ void stage_rc(int b, int& R, int& C) { const int st = b / 1024, sb = b % 1024, swz = sb ^ (((sb >> 9) & 1) << 5); R = (st >> 1) * 16 + swz / 64; C = (st & 1) * 32 + (swz % 64) / 2; }
__host__ __device__ __forceinline__ int perm32(int rho) { const int n = rho >> 4, i = rho & 15; return 8 * (i >> 2) + 4 * n + (i & 3); }

struct Unit { int pm, pn, tag; };
struct Gemm { const f16_t* A; const f16_t* Bt; int M, N, K; };

struct StaticOrder {
    int nM, nN, nwg, G, c;
    __host__ __device__ void init(int M, int N, int G_, int c_) { nM = M / BM; nN = N / BM; nwg = nM * nN; G = G_; c = c_; }
    __host__ __device__ bool next(int i, Unit& u) const { const long L = (long)i * G + c; if (L >= nwg) return false; decode(L, u); return true; }
    __host__ __device__ void decode(long L, Unit& u) const {
        int wgid = (int)L; { const int q = nwg / NXCD, r = nwg % NXCD, xcd = wgid % NXCD, off = wgid / NXCD; wgid = (xcd < r ? xcd * (q + 1) : r * (q + 1) + (xcd - r) * q) + off; }
        const int nig = WGM * nN, gid = wgid / nig, fm = gid * WGM, gsz = (nM - fm) < WGM ? (nM - fm) : WGM;
        u.pm = fm + ((wgid % nig) % gsz); u.pn = (wgid % nig) / gsz; u.tag = 0;
    }
    __device__ __forceinline__ void a_ready(const Unit&) const {}
    __device__ __forceinline__ void done(const Unit&) const {}
};

struct SubOrder : StaticOrder {
    int pm0, kind;
    __device__ void init2(int Mv, int N, int Gv, int c_, int pm0_, int kind_) { init(Mv, N, Gv, c_); pm0 = pm0_; kind = kind_; }
    __device__ bool next(int i, Unit& u) const {
        long L;
        if (kind == 0) L = (long)i * G + c;
        else if (kind == 1) { if (i >= 6) return false; L = i < 2 ? i * 256 + c : (2 + ((i - 2) >> 1)) * 256 + c + 128 * ((i - 2) & 1); }
        else { if (i >= 2) return false; L = i * 256 + c; }
        if (L >= nwg) return false;
        decode(L, u); u.pm += pm0; return true;
    }
};

struct SeamOrder {
    int mode, x, j, nj; unsigned* cnt;
    __device__ void init(int mode_, int c, unsigned* cnt_) { mode = mode_; x = c & 7; j = c >> 3; nj = mode_ == 0 ? 32 : 16; cnt = cnt_; }
    __device__ bool next(int i, Unit& u) const {
        const int s = i * nj + j;
        if (mode == 0) { if (s >= 28) return false; const int o = 2 * x + (s & 1), ii = o & 3; u.pm = 32 + 16 * (o >> 2) + (ii < 2 ? ii : 12 + ii); u.pn = s >> 1; u.tag = 0; return true; }
        if (s >= 140) return false;
        if (s < 28) { const int o = 2 * x + (s & 1), ii = o & 3; u.pm = 32 + 16 * (o >> 2) + (ii < 2 ? 2 + ii : 10 + ii); u.pn = s >> 1; u.tag = (s + nj >= 28) ? 1 : 0; }
        else if (s < 84) { const int s1 = s - 28, o = 4 * x + (s1 & 3); u.pm = 32 + 16 * (o >> 3) + 4 + (o & 7); u.pn = s1 >> 2; u.tag = (s + nj >= 84) ? 2 : 0; }
        else { const int s2 = s - 84; u.pm = 4 * x + (s2 & 3); u.pn = s2 >> 2; u.tag = 0; }
        return true;
    }
    __device__ __forceinline__ void a_ready(const Unit&) const {}
    __device__ __forceinline__ void done(const Unit& u) const {
        if (u.tag) { asm volatile("s_waitcnt vmcnt(0)" ::: "memory"); __builtin_amdgcn_s_barrier();
            if (threadIdx.x == 0) { __builtin_amdgcn_fence(__ATOMIC_RELEASE, "agent"); asm volatile("s_waitcnt vmcnt(0)" ::: "memory"); (void)__hip_atomic_fetch_add(cnt + (u.tag == 2 ? 64 : 0), 1u, __ATOMIC_RELAXED, __HIP_MEMORY_SCOPE_AGENT); } }
    }
};

typedef _Float16 f16x2 __attribute__((ext_vector_type(2)));
typedef float f32x2 __attribute__((ext_vector_type(2)));
__device__ __forceinline__ unsigned pk_f16(float lo, float hi) { f32x2 v = {lo, hi}; f16x2 h = __builtin_convertvector(v, f16x2); return __builtin_bit_cast(unsigned, h); }
__device__ __forceinline__ float f16lo(unsigned w) { f16x2 h = __builtin_bit_cast(f16x2, w); return (float)h.x; }
__device__ __forceinline__ float f16hi(unsigned w) { f16x2 h = __builtin_bit_cast(f16x2, w); return (float)h.y; }
__device__ __forceinline__ float fast_sigmoid(float x) { return __builtin_amdgcn_rcpf(1.0f + __expf(-x)); }
__device__ __forceinline__ float gelu_tanh(float x) { const float y = 1.5957691216057308f * (x + 0.044715f * x * x * x); return x * __builtin_amdgcn_rcpf(1.0f + __expf(-y)); }
template <int ACT> __device__ __forceinline__ float act_fn(float x) {
    if (ACT == 1) return gelu_tanh(x);
    if (ACT == 2) return fast_sigmoid(x);
    if (ACT == 3) { const float r = x > 0.f ? x : 0.f; return r * r; }
    return x;
}
template <int ACT> struct EpiH16 {
    static constexpr bool PERM = true, AFTER_DRAIN = false;
    f16_t* O; int ldc; int split_cols; size_t split_stride;
    __device__ __forceinline__ void operator()(const f32x4 (&acc)[2][2][4][2], const Unit& u, int wr, int wc, int fr, int fq) const {
        const int row0 = u.pm * BM + wr * 64 + fr; int colt = u.pn * BM; f16_t* base = O;
        if (split_cols) { const int t = colt / split_cols; base += (size_t)t * split_stride; colt -= t * split_cols; }
        const int col0 = colt + wc * 32 + 8 * fq;
#pragma unroll
        for (int ai = 0; ai < 2; ++ai)
#pragma unroll
            for (int m = 0; m < 4; ++m) { f16_t* rowp = base + (size_t)(row0 + ai * HALF + m * 16) * ldc + col0;
#pragma unroll
                for (int bj = 0; bj < 2; ++bj) { const f32x4 v0 = acc[ai][bj][m][0], v1 = acc[ai][bj][m][1];
                    u32x4 w; w.x = pk_f16(act_fn<ACT>(v0[0]), act_fn<ACT>(v0[1])); w.y = pk_f16(act_fn<ACT>(v0[2]), act_fn<ACT>(v0[3]));
                    w.z = pk_f16(act_fn<ACT>(v1[0]), act_fn<ACT>(v1[1])); w.w = pk_f16(act_fn<ACT>(v1[2]), act_fn<ACT>(v1[3]));
                    *(u32x4*)(rowp + bj * HALF) = w; } }
    }
};
template <int ACT> struct EpiH16B {
    static constexpr bool PERM = true, AFTER_DRAIN = false;
    f16_t* O; int ldc;
    __device__ __forceinline__ void operator()(const f32x4 (&acc)[2][2][4][2], const Unit& u, int wr, int wc, int fr, int fq) const {
        f16_t* base = O + (size_t)u.pm * BM * ldc + (size_t)(wr * 64 + fr) * BK;
#pragma unroll
        for (int bj = 0; bj < 2; ++bj) { const int c = u.pn * BM + bj * HALF + wc * 32 + 8 * fq; f16_t* cp = base + (size_t)(c >> 6) * (BM * BK) + (c & 63);
#pragma unroll
            for (int ai = 0; ai < 2; ++ai)
#pragma unroll
                for (int m = 0; m < 4; ++m) { const f32x4 v0 = acc[ai][bj][m][0], v1 = acc[ai][bj][m][1];
                    u32x4 w; w.x = pk_f16(act_fn<ACT>(v0[0]), act_fn<ACT>(v0[1])); w.y = pk_f16(act_fn<ACT>(v0[2]), act_fn<ACT>(v0[3]));
                    w.z = pk_f16(act_fn<ACT>(v1[0]), act_fn<ACT>(v1[1])); w.w = pk_f16(act_fn<ACT>(v1[2]), act_fn<ACT>(v1[3]));
                    *(u32x4*)(cp + (ai * HALF + m * 16) * BK) = w; } }
    }
};
template <bool ADD> struct EpiMix {
    static constexpr bool PERM = true, AFTER_DRAIN = false;
    f16_t* MIX; const f16_t* G; int gcol;
    __device__ __forceinline__ void operator()(const f32x4 (&acc)[2][2][4][2], const Unit& u, int wr, int wc, int fr, int fq) const {
        const int row0 = u.pm * BM + wr * 64 + fr; const int col0 = u.pn * BM + wc * 32 + 8 * fq;
#pragma unroll
        for (int ai = 0; ai < 2; ++ai)
#pragma unroll
            for (int m = 0; m < 4; ++m) { const size_t row = (size_t)(row0 + ai * HALF + m * 16);
#pragma unroll
                for (int bj = 0; bj < 2; ++bj) { const f32x4 v0 = acc[ai][bj][m][0], v1 = acc[ai][bj][m][1];
                    const u32x4 g = *(const u32x4*)(G + row * 2048 + gcol + col0 + bj * HALF);
                    float o[8] = {v0[0] * f16lo(g.x), v0[1] * f16hi(g.x), v0[2] * f16lo(g.y), v0[3] * f16hi(g.y), v1[0] * f16lo(g.z), v1[1] * f16hi(g.z), v1[2] * f16lo(g.w), v1[3] * f16hi(g.w)};
                    f16_t* p = MIX + row * 1024 + col0 + bj * HALF;
                    if (ADD) { const u32x4 q = *(const u32x4*)p; o[0] += f16lo(q.x); o[1] += f16hi(q.x); o[2] += f16lo(q.y); o[3] += f16hi(q.y); o[4] += f16lo(q.z); o[5] += f16hi(q.z); o[6] += f16lo(q.w); o[7] += f16hi(q.w); }
                    u32x4 w; w.x = pk_f16(o[0], o[1]); w.y = pk_f16(o[2], o[3]); w.z = pk_f16(o[4], o[5]); w.w = pk_f16(o[6], o[7]);
                    *(u32x4*)p = w; } }
    }
};
struct EpiRes {
    static constexpr bool PERM = false, AFTER_DRAIN = false;
    const float* base_ctx; const float* base_lat; float* X; const float* gate;
    __device__ __forceinline__ void operator()(const f32x4 (&acc)[2][2][4][2], const Unit& u, int wr, int wc, int fr, int fq) const {
        const int row0 = u.pm * BM + wr * 64 + fr, col0 = u.pn * BM + wc * 32 + 4 * fq;
        const int s = u.pm < 32 ? 0 : 1 + ((u.pm - 32) >> 4);
        const float* gp = gate + s * 6144 + col0;
        f32x4 gv[2][2];
#pragma unroll
        for (int bj = 0; bj < 2; ++bj)
#pragma unroll
            for (int n = 0; n < 2; ++n) gv[bj][n] = *(const f32x4*)(gp + bj * HALF + n * 16);
#pragma unroll
        for (int ai = 0; ai < 2; ++ai)
#pragma unroll
            for (int m = 0; m < 4; ++m) { const int row = row0 + ai * HALF + m * 16;
                const float* bp = (row < 8192 ? base_ctx + (size_t)row * 1024 : base_lat + (size_t)(row - 8192) * 1024) + col0;
                float* xp = X + (size_t)row * 1024 + col0;
#pragma unroll
                for (int bj = 0; bj < 2; ++bj)
#pragma unroll
                    for (int n = 0; n < 2; ++n) { const f32x4 b = *(const f32x4*)(bp + bj * HALF + n * 16); *(f32x4*)(xp + bj * HALF + n * 16) = b + gv[bj][n] * acc[ai][bj][m][n]; } }
    }
};
template <bool FINAL> struct EpiResNorm {
    static constexpr bool PERM = false, AFTER_DRAIN = true;
    const float* base_ctx; const float* base_lat; float* X; const float* gate;
    f16_t* H; const float* gain; const float* modn; int sh_idx, sc_idx;
    float* xbuf; unsigned* cnt; float eps;
    __device__ __forceinline__ void fused(f32x4 (&acc)[2][2][4][2], const Unit& u, int wr, int wc, int fr, int fq, PG8_LAS unsigned char* lds, int wid, int lane) const {
        PG8_LAS float* P = (PG8_LAS float*)lds; PG8_LAS float* S = (PG8_LAS float*)(lds + 8192);
        const int row0 = u.pm * BM + wr * 64 + fr, col0 = u.pn * BM + wc * 32 + 4 * fq;
        const int s = u.pm < 32 ? 0 : 1 + ((u.pm - 32) >> 4);
        {
            const float* gp = gate + s * 6144 + col0;
            f32x4 gv[2][2];
#pragma unroll
            for (int bj = 0; bj < 2; ++bj)
#pragma unroll
                for (int n = 0; n < 2; ++n) gv[bj][n] = *(const f32x4*)(gp + bj * HALF + n * 16);
#pragma unroll
            for (int ai = 0; ai < 2; ++ai)
#pragma unroll
                for (int m = 0; m < 4; ++m) { const int row = row0 + ai * HALF + m * 16;
                    const float* bp = (row < 8192 ? base_ctx + (size_t)row * 1024 : base_lat + (size_t)(row - 8192) * 1024) + col0;
                    float* xp = X + (size_t)row * 1024 + col0; float ss = 0.f;
#pragma unroll
                    for (int bj = 0; bj < 2; ++bj)
#pragma unroll
                        for (int n = 0; n < 2; ++n) { const f32x4 b = *(const f32x4*)(bp + bj * HALF + n * 16); const f32x4 x = b + gv[bj][n] * acc[ai][bj][m][n]; acc[ai][bj][m][n] = x;
                            if (!FINAL) *(f32x4*)(xp + bj * HALF + n * 16) = x;
                            ss += (x[0] * x[0] + x[1] * x[1]) + (x[2] * x[2] + x[3] * x[3]); }
                    ss += __shfl_xor(ss, 16); ss += __shfl_xor(ss, 32);
                    if (fq == 0) P[(ai * HALF + wr * 64 + m * 16 + fr) * 4 + wc] = ss;
                    asm volatile("" ::: "memory"); }
        }
        asm volatile("s_waitcnt lgkmcnt(0)" ::: "memory"); __builtin_amdgcn_s_barrier(); asm volatile("" ::: "memory");
        const int row = wid * 32 + (lane & 31);
        if (lane < 32) { const f32x4 p = *(const PG8_LAS f32x4*)(P + row * 4);
            __hip_atomic_store(xbuf + ((size_t)(u.pm * BM + row) * 4 + u.pn), (p[0] + p[1]) + (p[2] + p[3]), __ATOMIC_RELAXED, __HIP_MEMORY_SCOPE_AGENT); }
        asm volatile("s_waitcnt vmcnt(0)" ::: "memory");
        if (lane == 0) (void)__hip_atomic_fetch_add(cnt + 64 * u.pm, 1u, __ATOMIC_RELAXED, __HIP_MEMORY_SCOPE_AGENT);
        if (wid == 0) { unsigned spins = 0;
            while ((unsigned)__builtin_amdgcn_readfirstlane(__hip_atomic_load(cnt + 64 * u.pm, __ATOMIC_RELAXED, __HIP_MEMORY_SCOPE_AGENT)) < 32u) { __builtin_amdgcn_s_sleep(2); if (++spins > (1u << 22)) break; }
            __builtin_amdgcn_fence(__ATOMIC_ACQUIRE, "agent"); }
        asm volatile("s_waitcnt vmcnt(0) lgkmcnt(0)" ::: "memory"); __builtin_amdgcn_s_barrier(); asm volatile("" ::: "memory");
        if (lane < 32) { const float* sl = xbuf + (size_t)(u.pm * BM + row) * 4; float t = 0.f;
#pragma unroll
            for (int k = 0; k < 4; ++k) t += __hip_atomic_load(sl + k, __ATOMIC_RELAXED, __HIP_MEMORY_SCOPE_AGENT);
            S[row] = __builtin_amdgcn_rsqf(t * (1.0f / 1024.0f) + eps); }
        asm volatile("s_waitcnt lgkmcnt(0)" ::: "memory"); __builtin_amdgcn_s_barrier(); asm volatile("" ::: "memory");
#pragma unroll
        for (int bj = 0; bj < 2; ++bj)
#pragma unroll
            for (int n = 0; n < 2; ++n) { const int c = col0 + bj * HALF + n * 16;
                f32x4 gm = *(const f32x4*)(gain + c), sh = {0.f, 0.f, 0.f, 0.f};
                if (!FINAL) { gm = gm * (*(const f32x4*)(modn + (size_t)s * 6144 + sc_idx * 1024 + c) + 1.0f); sh = *(const f32x4*)(modn + (size_t)s * 6144 + sh_idx * 1024 + c); }
#pragma unroll
                for (int ai = 0; ai < 2; ++ai)
#pragma unroll
                    for (int m = 0; m < 4; ++m) { const int r = ai * HALF + wr * 64 + m * 16 + fr; const float rs = S[r]; const size_t off = (size_t)(u.pm * BM + r) * 1024 + c;
                        const f32x4 y = acc[ai][bj][m][n] * rs * gm + sh;
                        if (FINAL) *(f32x4*)(X + off) = y;
                        else { typedef unsigned u32x2p __attribute__((ext_vector_type(2))); u32x2p w; w.x = pk_f16(y[0], y[1]); w.y = pk_f16(y[2], y[3]); *(u32x2p*)(H + off) = w; } }
            }
    }
};

template <class Epi, class Sched, bool ALIGN_EPI = false, bool SP2 = false, bool ABLK = false>
__device__ __forceinline__ void gemm_phase(PG8_LAS unsigned char* lds, const Gemm g, const Sched& S, const Epi& E) {
    const int tid = threadIdx.x, wid = __builtin_amdgcn_readfirstlane(tid >> 6), lane = tid & 63, wr = wid >> 2, wc = wid & 3, fr = lane & 15, fq = lane >> 4;
    const int K = g.K, nt = K / BK;
    unsigned voffA[2], voffB[2];
#pragma unroll
    for (int i = 0; i < 2; ++i) { int R, C; stage_rc(tid * 16 + i * 8192, R, C); const int Rb = Epi::PERM ? ((R & ~31) + perm32(R & 31)) : R;
        voffA[i] = (unsigned)(R * (ABLK ? BK : K) + C) * 2u; voffB[i] = (unsigned)(Rb * K + C) * 2u; }
    const size_t kstep = (size_t)(BK * 2);
    const size_t hstep = (size_t)HALF * K * 2;
    const size_t tstep = 2 * hstep;
    const size_t kstepA = ABLK ? (size_t)BM * BK * 2 : kstep, hstepA = ABLK ? (size_t)HALF * BK * 2 : hstep;
    const unsigned ldsw = (unsigned)wid * 1024u;
    const int aoff = lds_byte(wr * 64 + fr, fq * 8), boff = lds_byte(wc * 32 + fr, fq * 8);
#define PG8_SA(b, h) (((b) * 2 + (h)) * HTB)
#define PG8_SB(b, h) ((4 + (b) * 2 + (h)) * HTB)
#define PG8_STAGE(bufoff, gbase, voff) do { _Pragma("unroll") for (int _i = 0; _i < 2; ++_i) \
        __builtin_amdgcn_global_load_lds((const unsigned*)((const char*)(gbase) + (voff)[_i]), (PG8_LAS unsigned*)(lds + (bufoff) + ldsw + _i * 8192), 16, 0, 0); } while (0)
#define PG8_LDA(dst, b, h) do { _Pragma("unroll") for (int m = 0; m < 4; ++m) _Pragma("unroll") for (int k = 0; k < 2; ++k) dst[m][k] = *(const PG8_LAS f16x8*)(lds + PG8_SA(b, h) + aoff + m * 2048 + k * 1024); } while (0)
#define PG8_LDB(dst, b, h) do { _Pragma("unroll") for (int n = 0; n < 2; ++n) _Pragma("unroll") for (int k = 0; k < 2; ++k) dst[n][k] = *(const PG8_LAS f16x8*)(lds + PG8_SB(b, h) + boff + n * 2048 + k * 1024); } while (0)
#define PG8_MMA(ai, bj, At, Bt) do { __builtin_amdgcn_s_setprio(1); _Pragma("unroll") for (int m = 0; m < 4; ++m) _Pragma("unroll") for (int n = 0; n < 2; ++n) _Pragma("unroll") for (int k = 0; k < 2; ++k) \
        acc[ai][bj][m][n] = __builtin_amdgcn_mfma_f32_16x16x32_f16(Bt[n][k], At[m][k], acc[ai][bj][m][n], 0, 0, 0); __builtin_amdgcn_s_setprio(0); } while (0)
#define PG8_WAIT_V(n) asm volatile("s_waitcnt vmcnt(" #n ")" ::: "memory")
#define PG8_WAIT_L(n) asm volatile("s_waitcnt lgkmcnt(" #n ")" ::: "memory")
#define PG8_BAR __builtin_amdgcn_s_barrier()
#define PG8_SCHED __builtin_amdgcn_sched_barrier(0)
    Unit cur, nxt; int ui = 0;
    if (!S.next(0, cur)) return;
    f32x4 acc[2][2][4][2];
#pragma unroll
    for (int a = 0; a < 2; ++a)
#pragma unroll
        for (int b = 0; b < 2; ++b)
#pragma unroll
            for (int m = 0; m < 4; ++m)
#pragma unroll
                for (int n = 0; n < 2; ++n) acc[a][b][m][n] = (f32x4){0.f, 0.f, 0.f, 0.f};
    f16x8 At[4][2], B0[2][2], B1[2][2];
    const char* cA = (const char*)g.A + (size_t)cur.pm * tstep; const char* cB = (const char*)g.Bt + (size_t)cur.pn * tstep;
    S.a_ready(cur);
    if constexpr (SP2) {
        PG8_STAGE(PG8_SB(0, 0), cB, voffB); PG8_STAGE(PG8_SB(0, 1), cB + hstep, voffB); PG8_STAGE(PG8_SA(0, 0), cA, voffA); PG8_STAGE(PG8_SA(0, 1), cA + hstepA, voffA);
        if (wr == 1) PG8_BAR;
        PG8_WAIT_V(2); PG8_BAR;
        PG8_STAGE(PG8_SB(1, 0), cB + kstep, voffB); PG8_STAGE(PG8_SA(1, 0), cA + kstepA, voffA); PG8_STAGE(PG8_SB(1, 1), cB + hstep + kstep, voffB);
        PG8_WAIT_V(6); PG8_BAR;
    } else {
        PG8_STAGE(PG8_SB(0, 0), cB, voffB); PG8_STAGE(PG8_SA(0, 0), cA, voffA); PG8_STAGE(PG8_SB(0, 1), cB + hstep, voffB); PG8_STAGE(PG8_SA(0, 1), cA + hstepA, voffA);
        if (wr == 1) PG8_BAR;
        PG8_WAIT_V(4); PG8_BAR;
        PG8_STAGE(PG8_SB(1, 0), cB + kstep, voffB); PG8_STAGE(PG8_SA(1, 0), cA + kstepA, voffA); PG8_STAGE(PG8_SB(1, 1), cB + hstep + kstep, voffB);
        PG8_WAIT_V(6); PG8_BAR;
    }
    for (;;) {
        const bool has_next = S.next(ui + 1, nxt);
        const char* nA = has_next ? (const char*)g.A + (size_t)nxt.pm * tstep : cA; const char* nB = has_next ? (const char*)g.Bt + (size_t)nxt.pn * tstep : cB;
        for (int t = 0; t < nt; t += 2) {
            const bool last = (t == nt - 2);
            const char* a1 = cA + (size_t)(t + 1) * kstepA;
            const char* a2 = last ? nA : cA + (size_t)(t + 2) * kstepA; const char* b2 = last ? nB : cB + (size_t)(t + 2) * kstep;
            const char* a3 = a2 + kstepA; const char* b3 = b2 + kstep;
            if (last && has_next) S.a_ready(nxt);
            if constexpr (SP2) {
            PG8_LDB(B0, 0, 0); PG8_LDB(B1, 0, 1); PG8_SCHED; PG8_LDA(At, 0, 0); PG8_STAGE(PG8_SA(1, 1), a1 + hstepA, voffA);
            PG8_WAIT_V(8); PG8_WAIT_L(0); PG8_BAR; PG8_MMA(0, 0, At, B0); PG8_MMA(0, 1, At, B1); PG8_BAR; PG8_SCHED;
            PG8_LDA(At, 0, 1); PG8_STAGE(PG8_SB(0, 0), b2, voffB); PG8_STAGE(PG8_SB(0, 1), b2 + hstep, voffB); PG8_STAGE(PG8_SA(0, 0), a2, voffA);
            PG8_WAIT_V(8); PG8_WAIT_L(0); PG8_BAR; PG8_MMA(1, 0, At, B0); PG8_MMA(1, 1, At, B1); PG8_BAR; PG8_SCHED;
            PG8_LDB(B0, 1, 0); PG8_LDB(B1, 1, 1); PG8_SCHED; PG8_LDA(At, 1, 0); PG8_STAGE(PG8_SA(0, 1), a2 + hstepA, voffA);
            PG8_WAIT_V(8); PG8_WAIT_L(0); PG8_BAR; PG8_MMA(0, 0, At, B0); PG8_MMA(0, 1, At, B1); PG8_BAR; PG8_SCHED;
            PG8_LDA(At, 1, 1); PG8_STAGE(PG8_SB(1, 0), b3, voffB); PG8_STAGE(PG8_SB(1, 1), b3 + hstep, voffB); PG8_STAGE(PG8_SA(1, 0), a3, voffA);
            PG8_WAIT_V(8); PG8_WAIT_L(0); PG8_BAR; PG8_MMA(1, 0, At, B0); PG8_MMA(1, 1, At, B1); PG8_BAR; PG8_SCHED;
            } else {
            PG8_LDB(B0, 0, 0); PG8_SCHED; PG8_LDA(At, 0, 0); PG8_STAGE(PG8_SA(1, 1), a1 + hstepA, voffA);
            PG8_WAIT_L(8); PG8_BAR; PG8_WAIT_L(0); PG8_MMA(0, 0, At, B0); PG8_BAR; PG8_SCHED;
            PG8_LDB(B1, 0, 1); PG8_STAGE(PG8_SB(0, 0), b2, voffB);
            PG8_BAR; PG8_WAIT_L(0); PG8_MMA(0, 1, At, B1); PG8_BAR;
            PG8_LDA(At, 0, 1); PG8_STAGE(PG8_SA(0, 0), a2, voffA);
            PG8_BAR; PG8_WAIT_L(0); PG8_MMA(1, 0, At, B0); PG8_BAR; PG8_SCHED;
            PG8_STAGE(PG8_SB(0, 1), b2 + hstep, voffB);
            PG8_WAIT_V(6); PG8_BAR; PG8_MMA(1, 1, At, B1); PG8_BAR;
            PG8_LDB(B0, 1, 0); PG8_SCHED; PG8_LDA(At, 1, 0); PG8_STAGE(PG8_SA(0, 1), a2 + hstepA, voffA);
            PG8_WAIT_L(8); PG8_BAR; PG8_WAIT_L(0); PG8_MMA(0, 0, At, B0); PG8_BAR; PG8_SCHED;
            PG8_LDB(B1, 1, 1); PG8_STAGE(PG8_SB(1, 0), b3, voffB);
            PG8_BAR; PG8_WAIT_L(0); PG8_MMA(0, 1, At, B1); PG8_BAR;
            PG8_LDA(At, 1, 1); PG8_STAGE(PG8_SA(1, 0), a3, voffA);
            PG8_BAR; PG8_WAIT_L(0); PG8_MMA(1, 0, At, B0); PG8_BAR; PG8_SCHED;
            PG8_STAGE(PG8_SB(1, 1), b3 + hstep, voffB);
            PG8_WAIT_V(6); PG8_BAR; PG8_MMA(1, 1, At, B1); PG8_BAR;
            }
        }
        if constexpr (ALIGN_EPI) { if (wr == 0) PG8_BAR; }
        if constexpr (!Epi::AFTER_DRAIN) { E(acc, cur, wr, wc, fr, fq); S.done(cur); }
        if (!has_next) break;
#pragma unroll
        for (int a = 0; a < 2; ++a)
#pragma unroll
            for (int b = 0; b < 2; ++b)
#pragma unroll
                for (int m = 0; m < 4; ++m)
#pragma unroll
                    for (int n = 0; n < 2; ++n) acc[a][b][m][n] = (f32x4){0.f, 0.f, 0.f, 0.f};
        cur = nxt; cA = nA; cB = nB; ++ui;
        if constexpr (ALIGN_EPI) { if (wr == 1) PG8_BAR; }
    }
    PG8_WAIT_V(0);
    if constexpr (!ALIGN_EPI) { if (wr == 0) PG8_BAR; }
    PG8_BAR;
    if constexpr (Epi::AFTER_DRAIN) { E.fused(acc, cur, wr, wc, fr, fq, lds, wid, lane); S.done(cur); }
#undef PG8_SA
#undef PG8_SB
#undef PG8_STAGE
#undef PG8_LDA
#undef PG8_LDB
#undef PG8_MMA
#undef PG8_WAIT_V
#undef PG8_WAIT_L
#undef PG8_BAR
#undef PG8_SCHED
}
}

constexpr int NWAVES = 8, NTHR = 512;
constexpr int D = 1024, MCTX = 8192, MLAT = 16384, M = MCTX + MLAT;
constexpr int TCTX = 256, TLAT = 4096, BCTX = 32, BLAT = 4, NH = 16, HD = 64;
constexpr int DIN = 7552, CRW = 3456, ZRN = 3584, DFF = 4096;
constexpr int NLAYER = 2;
constexpr float EPS = 1e-6f, GN_EPS = 64e-5f, DECAY_SCALE = 0.6065306597126334f;
enum { I_XP = 0, I_XS, I_STATE, I_C, I_CCTX, I_WADA, I_BADA, I_N1G, I_N2G, I_WIN, I_MU, I_W0, I_WUP, I_A0, I_AUP, I_GUP, I_KK, I_KA, I_RK, I_LNXG, I_LNXB, I_WBA, I_LNVG, I_WS, I_BS, I_WBB, I_WOUT, I_W1, I_W2, I_FING, N_IN };

constexpr size_t MiB = 1u << 20;
constexpr size_t WS_CTL = 0, CTL_ZERO_BYTES = 1 * MiB;
constexpr size_t WS_MOD = 1 * MiB;
constexpr size_t WS_BON = 2 * MiB;
constexpr size_t WS_SMALL = 4 * MiB;
constexpr size_t SM_WUP = 0, SM_AUP = 524288, SM_GUP = 1048576, SM_WS = 1572864;
constexpr size_t WS_W16 = 8 * MiB;
constexpr size_t W_INR = 0, W_INUV = (size_t)3584 * 1024, W_ING = (size_t)5632 * 1024, W_A = (size_t)7680 * 1024, W_B = (size_t)8704 * 1024, W_OUT = (size_t)9728 * 1024,
                 W_1 = (size_t)10752 * 1024, W_2 = (size_t)14848 * 1024, W_END = (size_t)18944 * 1024;
constexpr size_t WS_B = 48 * MiB;
constexpr size_t WS_BIG = 96 * MiB;
constexpr size_t WS_END = 288 * MiB;
static_assert(WS_W16 + W_END * 2 <= WS_B && WS_BIG + (size_t)M * DFF * 2 <= WS_END && (size_t)M * ZRN * 2 <= 192 * MiB, "ws map");

constexpr int RING_BYTES = 131072;
constexpr int LDS_BYTES = 147456;

#define LAS __attribute__((address_space(3)))
typedef _Float16 f16;
typedef _Float16 f16x4 __attribute__((ext_vector_type(4)));
typedef _Float16 f16x8 __attribute__((ext_vector_type(8)));
typedef float f32x4 __attribute__((ext_vector_type(4)));
typedef unsigned u32x2 __attribute__((ext_vector_type(2)));
typedef unsigned u32x4 __attribute__((ext_vector_type(4)));
typedef short v4i16_t __attribute__((ext_vector_type(4)));
using pg8::pk_f16; using pg8::f16lo; using pg8::f16hi; using pg8::fast_sigmoid;

struct Args { const float* in[N_IN]; float* out; unsigned char* ws; int ph_lo, ph_hi; };
static_assert(sizeof(Args) == N_IN * 8 + 8 + 8 + 8, "Args has no padding");

__device__ __forceinline__ float wave_sum(float v) {
#pragma unroll
    for (int o = 1; o < 64; o <<= 1) v += __shfl_xor(v, o);
    return v;
}
#define LDS_WAIT() asm volatile("s_waitcnt lgkmcnt(0)" ::: "memory")

__host__ __device__ __forceinline__ int perm_o(int p) { return 4 * (p & 15) + (p >> 4); }
__host__ __device__ __forceinline__ int perm_inv(int c) { return ((c & 3) << 4) + (c >> 2); }
__device__ __forceinline__ void transpose_item(const float* W, int K, int N, f16* WT, int split, int split_add, int permn_below, bool permk, LAS float* scr, int item, int lane) {
    const int nblk = N / 32, kb = item / nblk, nb = item % nblk, k0 = 64 * kb, n0 = 32 * nb;
#pragma unroll 8
    for (int i = 0; i < 32; ++i) { const int kk = 2 * i + (lane >> 5); const int ks = permk ? perm_o(kk) : kk; scr[kk * 33 + (lane & 31)] = W[(size_t)(k0 + ks) * N + n0 + (lane & 31)]; }
    LDS_WAIT(); asm volatile("" ::: "memory");
    const int c = lane & 7;
#pragma unroll
    for (int j = 0; j < 4; ++j) { const int n = (lane >> 3) + 8 * j; const LAS float* s = scr + (8 * c) * 33 + n; const int ng = n0 + n;
        const int drow = ng < permn_below ? (ng & ~63) + perm_inv(ng & 63) : ng + (ng >= split ? split_add : 0);
        u32x4 o; o.x = pk_f16(s[0 * 33], s[1 * 33]); o.y = pk_f16(s[2 * 33], s[3 * 33]); o.z = pk_f16(s[4 * 33], s[5 * 33]); o.w = pk_f16(s[6 * 33], s[7 * 33]);
        *(u32x4*)(WT + (size_t)drow * K + k0 + 8 * c) = o; }
    LDS_WAIT(); asm volatile("" ::: "memory");
}
__device__ __forceinline__ void convert_layer_weights(const Args& a, int z, int l, LAS unsigned char* lds, int gw, int ngw, int wave, int lane, int gtid, int ngt) {
    LAS float* scr = (LAS float*)(lds + wave * 16384);
    f16* W16 = (f16*)(a.ws + WS_W16);
    constexpr int I_IN = 16 * (DIN / 32), I_SQ = 16 * 32, I_1 = 16 * (DFF / 32), I_2 = (DFF / 64) * 32;
    constexpr int NITEMS = I_IN + 3 * I_SQ + I_1 + I_2;
    for (int it = gw; it < NITEMS; it += ngw) {
        int r = it;
        if (r < I_IN) { transpose_item(a.in[z + I_WIN] + (size_t)l * D * DIN, D, DIN, W16 + W_INR, CRW, 128, CRW, false, scr, r, lane); continue; } r -= I_IN;
        if (r < I_SQ) { transpose_item(a.in[z + I_WBA] + (size_t)l * D * D, D, D, W16 + W_A, 1 << 30, 0, 0, true, scr, r, lane); continue; } r -= I_SQ;
        if (r < I_SQ) { transpose_item(a.in[z + I_WBB] + (size_t)l * D * D, D, D, W16 + W_B, 1 << 30, 0, 0, false, scr, r, lane); continue; } r -= I_SQ;
        if (r < I_SQ) { transpose_item(a.in[z + I_WOUT] + (size_t)l * D * D, D, D, W16 + W_OUT, 1 << 30, 0, 0, false, scr, r, lane); continue; } r -= I_SQ;
        if (r < I_1) { transpose_item(a.in[z + I_W1] + (size_t)l * D * DFF, D, DFF, W16 + W_1, 1 << 30, 0, 0, false, scr, r, lane); continue; } r -= I_1;
        transpose_item(a.in[z + I_W2] + (size_t)l * DFF * D, DFF, D, W16 + W_2, 1 << 30, 0, 0, false, scr, r, lane);
    }
    u32x4* pad = (u32x4*)(W16 + W_INR + (size_t)CRW * 1024);
    for (int i = gtid; i < 128 * 1024 / 8; i += ngt) pad[i] = (u32x4){0u, 0u, 0u, 0u};
}
__device__ __forceinline__ void p0_prologue(const Args& a, int z, LAS unsigned char* lds, int G, int bx, int tid, int wave, int lane) {
    const int gw = bx * NWAVES + wave, ngw = G * NWAVES, gtid = bx * NTHR + tid, ngt = G * NTHR;
    {
        LAS float* SC = (LAS float*)lds;
        LAS float* P = (LAS float*)(lds + 20480);
        float* MOD = (float*)(a.ws + WS_MOD);
        bool have_sc = false;
        for (int item = bx; item < NLAYER * 96; item += G) {
            if (!have_sc) {
                for (int i = tid; i < 5 * 1024; i += NTHR) { const float x = (i < 1024) ? a.in[z + I_CCTX][i] : a.in[z + I_C][i - 1024]; SC[i] = x * fast_sigmoid(x); }
                have_sc = true;
            }
            __syncthreads();
            const int l = item / 96, n0 = (item % 96) * 64;
            const float* wp = a.in[z + I_WADA] + ((size_t)l * 1024 + wave * 128) * 6144 + n0 + lane;
            float acc[5] = {0.f, 0.f, 0.f, 0.f, 0.f};
#pragma unroll 8
            for (int kk = 0; kk < 128; ++kk) { const float wv = wp[(size_t)kk * 6144]; const int k = wave * 128 + kk;
#pragma unroll
                for (int s = 0; s < 5; ++s) acc[s] += SC[s * 1024 + k] * wv; }
#pragma unroll
            for (int s = 0; s < 5; ++s) P[(wave * 5 + s) * 64 + lane] = acc[s];
            __syncthreads();
            if (tid < 320) { const int s = tid >> 6, ln = tid & 63; float v = a.in[z + I_BADA][l * 6144 + n0 + ln];
#pragma unroll
                for (int w = 0; w < 8; ++w) v += P[(w * 5 + s) * 64 + ln];
                MOD[((size_t)l * 5 + s) * 6144 + n0 + ln] = v; }
        }
        __syncthreads();
    }
    {
        LAS float* scr = (LAS float*)(lds + wave * 16384);
        unsigned char* sm = a.ws + WS_SMALL;
        for (int it = gw; it < 128 + 128 + 128; it += ngw) {
            if (it < 128) { const int ld = it >> 5; transpose_item(a.in[z + I_WUP] + (size_t)ld * 64 * 1024, 64, 1024, (f16*)(sm + SM_WUP) + (size_t)ld * 1024 * 64, 1 << 30, 0, 0, true, scr, it & 31, lane); }
            else if (it < 256) { const int ld = (it - 128) >> 5; transpose_item(a.in[z + I_AUP] + (size_t)ld * 64 * 1024, 64, 1024, (f16*)(sm + SM_AUP) + (size_t)ld * 1024 * 64, 1 << 30, 0, 0, true, scr, it & 31, lane); }
            else { const int l = (it - 256) >> 6; transpose_item(a.in[z + I_GUP] + (size_t)l * 128 * 1024, 128, 1024, (f16*)(sm + SM_GUP) + (size_t)l * 1024 * 128, 1 << 30, 0, 0, true, scr, it & 63, lane); }
        }
        f16* ws16 = (f16*)(sm + SM_WS); const float* wsrc = a.in[z + I_WS];
        for (int i = gtid; i < NLAYER * 8 * 128 * 128 / 4; i += ngt) { const f32x4 v = *(const f32x4*)(wsrc + (size_t)i * 4); u32x2 o; o.x = pk_f16(v[0], v[1]); o.y = pk_f16(v[2], v[3]); *(u32x2*)(ws16 + (size_t)i * 4) = o; }
    }
    convert_layer_weights(a, z, 0, lds, gw, ngw, wave, lane, gtid, ngt);
}

__device__ __forceinline__ const float* xrow_ptr(const float* base_ctx, const float* base_lat, int row) { return row < MCTX ? base_ctx + (size_t)row * D : base_lat + (size_t)(row - MCTX) * D; }
__device__ __forceinline__ int row_stream(int row) { return row < MCTX ? 0 : 1 + ((row - MCTX) >> 12); }
__device__ __forceinline__ void norm_phase(const float* base_ctx, const float* base_lat, const float* gain, const float* modl, int sh_idx, int sc_idx, f16* H, int gw, int ngw, int lane) {
    const int rpw = (M + ngw - 1) / ngw; const int r0 = gw * rpw, r1 = (r0 + rpw < M) ? r0 + rpw : M;
    int cur_s = -1; f32x4 gm[4], sh[4];
    f32x4 nv[4];
    if (r0 < r1) { const f32x4* xn = (const f32x4*)xrow_ptr(base_ctx, base_lat, r0) + lane;
#pragma unroll
        for (int j = 0; j < 4; ++j) nv[j] = xn[64 * j]; }
    for (int row = r0; row < r1; ++row) {
        const int s = row_stream(row);
        if (s != cur_s) { cur_s = s;
#pragma unroll
            for (int j = 0; j < 4; ++j) { const int c = 4 * lane + 256 * j; const f32x4 g = *(const f32x4*)(gain + c); const f32x4 sc = *(const f32x4*)(modl + (size_t)s * 6144 + sc_idx * 1024 + c);
                gm[j] = g * (sc + 1.0f); sh[j] = *(const f32x4*)(modl + (size_t)s * 6144 + sh_idx * 1024 + c); } }
        f32x4 v[4]; float ss = 0.f;
#pragma unroll
        for (int j = 0; j < 4; ++j) v[j] = nv[j];
        { const int rn = (row + 1 < r1) ? row + 1 : row; const f32x4* xn = (const f32x4*)xrow_ptr(base_ctx, base_lat, rn) + lane;
#pragma unroll
          for (int j = 0; j < 4; ++j) nv[j] = xn[64 * j]; }
#pragma unroll
        for (int j = 0; j < 4; ++j) ss += (v[j][0] * v[j][0] + v[j][1] * v[j][1]) + (v[j][2] * v[j][2] + v[j][3] * v[j][3]);
        const float rs = __builtin_amdgcn_rsqf(wave_sum(ss) * (1.0f / D) + EPS);
        u32x2* o = (u32x2*)(H + (size_t)row * D) + lane;
#pragma unroll
        for (int j = 0; j < 4; ++j) { const f32x4 y = v[j] * rs * gm[j] + sh[j]; u32x2 w; w.x = pk_f16(y[0], y[1]); w.y = pk_f16(y[2], y[3]); o[64 * j] = w; }
    }
}
__device__ __forceinline__ void final_norm_phase(float* X, const float* gain, int gw, int ngw, int lane) {
    f32x4 g[4];
#pragma unroll
    for (int j = 0; j < 4; ++j) g[j] = *(const f32x4*)(gain + 4 * lane + 256 * j);
    for (int row = gw; row < M; row += ngw) {
        f32x4* xr = (f32x4*)(X + (size_t)row * D) + lane;
        f32x4 v[4]; float ss = 0.f;
#pragma unroll
        for (int j = 0; j < 4; ++j) { v[j] = xr[64 * j]; ss += (v[j][0] * v[j][0] + v[j][1] * v[j][1]) + (v[j][2] * v[j][2] + v[j][3] * v[j][3]); }
        const float rs = __builtin_amdgcn_rsqf(wave_sum(ss) * (1.0f / D) + EPS);
#pragma unroll
        for (int j = 0; j < 4; ++j) xr[64 * j] = v[j] * rs * g[j];
    }
}

constexpr int SA_RH = 0, SA_KRH = 2304, SA_KNH = 4608, SA_WD = 6912, SA_AD = 9216, SA_GD = 11520, SA_SZ = 15872;
constexpr int L_SA = 0, L_VT = 31744, L_VS = 39424, L_AREF = 46336, L_RREF = 48640, L_BREF = 50944, L_KREF = 53248, L_A0T = 55552, L_R0 = 60672, L_BKT = 65280, L_EC = 75520,
              L_GF = 76032, L_BONP = 84736, L_AAB = 85248, L_AAK = 87296, L_UVT = 87808, L_APR = 92928, L_ARK = 95232, L_YO = 96512, L_MU = 100864, L_DIR = 102656;
static_assert(L_DIR <= LDS_BYTES, "scan LDS");
constexpr int HLD = 72;
constexpr int GD_LD = 136;
constexpr int TLD = 20;

#define FMAC_BC(acc, x, s, N) asm("v_fmac_f32_dpp %0, %1, %2 row_newbcast:" #N " row_mask:0xf bank_mask:0xf" : "+v"(acc) : "v"(x), "v"(s))
#define FS_COL(s) _Pragma("unroll") for (int t_ = s + 1; t_ < 16; ++t_) FMAC_BC(x[t_], arow[t_], x[s], s);
__device__ __forceinline__ void fwd_subst(float (&x)[16], const float (&arow)[16]) {
    FS_COL(0) FS_COL(1) FS_COL(2) FS_COL(3) FS_COL(4) FS_COL(5) FS_COL(6) FS_COL(7) FS_COL(8) FS_COL(9) FS_COL(10) FS_COL(11) FS_COL(12) FS_COL(13) FS_COL(14)
}
__device__ __forceinline__ float fast_tanh(float x) { return 1.0f - 2.0f * __builtin_amdgcn_rcpf(1.0f + __expf(2.0f * x)); }
template <int CTRL> __device__ __forceinline__ float dpp_f(float x) { return __builtin_bit_cast(float, __builtin_amdgcn_update_dpp(0, __builtin_bit_cast(int, x), CTRL, 0xf, 0xf, false)); }
__device__ __forceinline__ float red16(float v) { v += dpp_f<0x128>(v); v += dpp_f<0x124>(v); v += dpp_f<0x122>(v); v += dpp_f<0x121>(v); return v; }
__device__ __forceinline__ float h2f(unsigned short u) { return (float)__builtin_bit_cast(f16, u); }
__device__ __forceinline__ f32x4 tile_xyT(LAS unsigned char* X, LAS unsigned char* Y, int lane) {
    f32x4 acc = {0.f, 0.f, 0.f, 0.f};
    const int o = ((lane & 15) * HLD + 8 * (lane >> 4)) * 2;
#pragma unroll
    for (int ks = 0; ks < 2; ++ks) { const f16x8 fa = *(const LAS f16x8*)(X + o + 64 * ks), fb = *(const LAS f16x8*)(Y + o + 64 * ks); acc = __builtin_amdgcn_mfma_f32_16x16x32_f16(fa, fb, acc, 0, 0, 0); }
    return acc;
}

template <bool LAT> struct PreZ { u32x2 ctr[7]; u32x2 nbr[7]; };

template <bool LAT> __device__ __forceinline__ bool nbr_valid(int t, int q) {
    constexpr int T = LAT ? TLAT : TCTX;
    if (LAT) { const int col = t & 63, rw = t >> 6; return q == 0 ? col >= 1 : (q == 1 ? col < 63 : (q == 2 ? rw >= 1 : rw < 63)); }
    return (q & 1) ? (t + 1 < T) : (t >= 1);
}
template <bool LAT> __device__ __forceinline__ void pre_issue(PreZ<LAT>& P, const f16* Zr, size_t row_base, int c, int d, int h, int tg, bool want_g) {
    const int s = tg >> 4, g = tg & 15, q = g >> 2;
    const int t = 16 * c + (d ? 15 - s : s);
    const unsigned rowoff = (unsigned)((row_base + t) * (size_t)ZRN * 2 + 8 * g);
    const unsigned colb[7] = {(unsigned)(h * 128), (unsigned)(2048 + h * 128), (unsigned)(4096 + h * 128), (unsigned)(6144 + d * 128), (unsigned)(6400 + d * 128), 6656u, 6784u};
    const char* zb = (const char*)Zr;
    constexpr unsigned RS = ZRN * 2;
    unsigned dn;
    if (LAT) dn = q == 0 ? 0u - RS : (q == 1 ? RS : (q == 2 ? 0u - 64u * RS : 64u * RS));
    else dn = (q & 1) ? RS : 0u - RS;
    if (!nbr_valid<LAT>(t, q)) dn = 0u;
#pragma unroll
    for (int a = 0; a < 7; ++a) { const unsigned o = rowoff + colb[a];
        if (a >= 5 && !want_g) continue;
        P.ctr[a] = *(const u32x2*)(zb + o);
        P.nbr[a] = *(const u32x2*)(zb + (o + dn)); }
}
typedef _Float16 h2_t __attribute__((ext_vector_type(2)));
template <bool LAT> __device__ __forceinline__ u32x2 pre_mix(const PreZ<LAT>& P, int a, const u32x2 mu, bool valid) {
    const unsigned cx_ = P.ctr[a][0], cy_ = P.ctr[a][1], nx_ = valid ? P.nbr[a][0] : 0u, ny_ = valid ? P.nbr[a][1] : 0u, mx_ = mu[0], my_ = mu[1];
    const h2_t z0 = __builtin_bit_cast(h2_t, cx_);
    const h2_t z1 = __builtin_bit_cast(h2_t, cy_);
    const h2_t n0 = __builtin_bit_cast(h2_t, nx_);
    const h2_t n1 = __builtin_bit_cast(h2_t, ny_);
    const h2_t m0 = __builtin_bit_cast(h2_t, mx_);
    const h2_t m1 = __builtin_bit_cast(h2_t, my_);
    const h2_t r0 = z0 + m0 * (n0 - z0);
    const h2_t r1 = z1 + m1 * (n1 - z1);
    u32x2 r; r[0] = __builtin_bit_cast(unsigned, r0); r[1] = __builtin_bit_cast(unsigned, r1); return r;
}

template <bool LAT> __device__ __forceinline__ void scan_chain(const Args& a, int z, int l, LAS unsigned char* lds, int unit, int b, int h, int d, int tid, int wave, int lane, const unsigned* mid_cnt = nullptr) {
    constexpr int T = LAT ? TLAT : TCTX, NT = T / 16;
    const size_t row_base = LAT ? (size_t)MCTX + (size_t)b * TLAT : (size_t)b * TCTX;
    const f16* Zr = (const f16*)(a.ws + WS_BIG);
    f16* YA = l == 0 ? (f16*)a.out : (f16*)(a.ws + WS_B);
    float* BONG = (float*)(a.ws + WS_BON);
    unsigned* flag_mine = (unsigned*)(a.ws + WS_CTL) + 1024 + (((size_t)l * 576 + unit) * 2 + d) * 16;
    unsigned* flag_partner = (unsigned*)(a.ws + WS_CTL) + 1024 + (((size_t)l * 576 + unit) * 2 + (d ^ 1)) * 16;
    const bool helper = wave >= 4;
    const int q = wave & 3, tg = tid & 255, g4 = lane >> 4, c16 = lane & 15;
    LAS unsigned char* Ld = lds;
    const unsigned char* sm = a.ws + WS_SMALL;
    const int jl = 16 * q + c16;
    const int lcol = h * 64 + perm_o(jl), kq = 8 * g4;
    const f16* gu = (const f16*)(sm + SM_GUP) + ((size_t)l * 1024 + lcol) * 128 + kq;
    const f16* wu = (const f16*)(sm + SM_WUP) + ((size_t)(l * 2 + d) * 1024 + lcol) * 64 + kq;
    const f16* au = (const f16*)(sm + SM_AUP) + ((size_t)(l * 2 + d) * 1024 + lcol) * 64 + kq;
    const float* w0p = a.in[z + I_W0] + (size_t)(l * 2 + d) * 1024 + lcol; const float* a0p = a.in[z + I_A0] + (size_t)(l * 2 + d) * 1024 + lcol;
    const float* kap = a.in[z + I_KA] + l * 1024 + lcol; const float* rkp = a.in[z + I_RK] + l * 1024 + lcol;
    const int sA = tg >> 4, gA = tg & 15;
    const int chA = h * 64 + 4 * gA;
    if (helper && sA == 0) {
        const float* mu = a.in[z + I_MU] + (size_t)l * CRW;
        const int colbase[7] = {h * 64 + 4 * gA, 1024 + h * 64 + 4 * gA, 2048 + h * 64 + 4 * gA, 3072 + d * 64 + 4 * gA, 3200 + d * 64 + 4 * gA, 3328 + 4 * gA, 3392 + 4 * gA};
#pragma unroll
        for (int i = 0; i < 7; ++i) { const float* mb = mu + (colbase[i] - 4 * gA);
            u32x2 w; w.x = pk_f16(mb[perm_o(4 * gA)], mb[perm_o(4 * gA + 1)]); w.y = pk_f16(mb[perm_o(4 * gA + 2)], mb[perm_o(4 * gA + 3)]); *(LAS u32x2*)(Ld + L_MU + (i * 64 + 4 * gA) * 2) = w; }
    }
#define MUV(i) (*(const LAS u32x2*)(Ld + L_MU + ((i) * 64 + 4 * gA) * 2))
    f32x4 kkc4, lng4, lnb4;
#pragma unroll
    for (int e = 0; e < 4; ++e) { const int co = l * 1024 + h * 64 + perm_o(4 * gA + e); kkc4[e] = a.in[z + I_KK][co]; lng4[e] = a.in[z + I_LNXG][co]; lnb4[e] = a.in[z + I_LNXB][co]; }
    const unsigned kkw0_ = pk_f16(kkc4[0], kkc4[1]), kkw1_ = pk_f16(kkc4[2], kkc4[3]);
    const h2_t kkh0 = __builtin_bit_cast(h2_t, kkw0_);
    const h2_t kkh1 = __builtin_bit_cast(h2_t, kkw1_);
    float S[16];
    const size_t sidx = ((((size_t)b * 2 + l) * 2 + d) * 16 + h) * 4096 + (size_t)perm_o(16 * q + c16) * 64;
    if (LAT && !helper) { const float* sp = a.in[z + I_STATE] + sidx;
#pragma unroll
        for (int n = 0; n < 16; ++n) S[n] = sp[perm_o(32 * (n >> 3) + 8 * g4 + (n & 7))]; }
    else {
#pragma unroll
        for (int n = 0; n < 16; ++n) S[n] = 0.f; }
    for (int i = tid; i < 5120 / 4; i += NTHR) { *(LAS unsigned*)(Ld + L_BKT + 5120 + 4 * i) = 0u; *(LAS unsigned*)(Ld + L_UVT + 4 * i) = 0u; }
    for (int i = tid; i < 2304 / 4; i += NTHR) { *(LAS unsigned*)(Ld + L_R0 + 2304 + 4 * i) = 0u; *(LAS unsigned*)(Ld + L_APR + 4 * i) = 0u; }
    for (int i = tid; i < 1280 / 4; i += NTHR) *(LAS unsigned*)(Ld + L_ARK + 4 * i) = 0u;
    for (int i = tid; i < 2560 / 4; i += NTHR) *(LAS unsigned*)(Ld + L_VT + 2 * 2560 + 4 * i) = 0u;
    if (tid < 64) *(LAS float*)(Ld + L_EC + 256 + 4 * tid) = 1.0f;
    __syncthreads();
    PreZ<LAT> PA, PB;
    u32x2 yprev = {0u, 0u}; float bgprev = 0.f; bool flag_ok = false;

#define STAGE_A(nA, PX) do { const int cA_ = d ? NT - 1 - (nA) : (nA); const int vb = (nA) % 3; LAS unsigned char* SAw = Ld + L_SA + ((nA) & 1) * SA_SZ; const int tA = 16 * cA_ + (d ? 15 - sA : sA); const bool vA = nbr_valid<LAT>(tA, gA >> 2); \
            const u32x2 zr = pre_mix<LAT>(PX, 0, MUV(0), vA), zk = pre_mix<LAT>(PX, 1, MUV(1), vA), zv = pre_mix<LAT>(PX, 2, MUV(2), vA), zw = pre_mix<LAT>(PX, 3, MUV(3), vA), za = pre_mix<LAT>(PX, 4, MUV(4), vA); \
            const int o8 = (sA * HLD + 4 * gA) * 2; \
            *(LAS u32x2*)(SAw + SA_RH + o8) = zr; \
            *(LAS u32x2*)(SAw + SA_KRH + o8) = zk; \
            { const unsigned zk0_ = zk[0], zk1_ = zk[1]; const h2_t k0 = __builtin_bit_cast(h2_t, zk0_) * kkh0; const h2_t k1 = __builtin_bit_cast(h2_t, zk1_) * kkh1; \
              const float ss = red16(__builtin_amdgcn_fdot2(k0, k0, __builtin_amdgcn_fdot2(k1, k1, 0.f, false), false)); const float rn = __builtin_amdgcn_rsqf(ss + 1e-12f); \
              u32x2 w; w.x = pk_f16((float)k0.x * rn, (float)k0.y * rn); w.y = pk_f16((float)k1.x * rn, (float)k1.y * rn); *(LAS u32x2*)(SAw + SA_KNH + o8) = w; } \
            { const u32x2 w = zv; *(LAS u32x2*)(Ld + L_VS + vb * 2304 + o8) = w; \
              *(LAS unsigned short*)(Ld + L_VT + vb * 2560 + ((4 * gA + 0) * TLD + sA) * 2) = (unsigned short)(w.x & 0xffffu); *(LAS unsigned short*)(Ld + L_VT + vb * 2560 + ((4 * gA + 1) * TLD + sA) * 2) = (unsigned short)(w.x >> 16); \
              *(LAS unsigned short*)(Ld + L_VT + vb * 2560 + ((4 * gA + 2) * TLD + sA) * 2) = (unsigned short)(w.y & 0xffffu); *(LAS unsigned short*)(Ld + L_VT + vb * 2560 + ((4 * gA + 3) * TLD + sA) * 2) = (unsigned short)(w.y >> 16); } \
            { u32x2 w; w.x = pk_f16(fast_tanh(f16lo(zw.x)), fast_tanh(f16hi(zw.x))); w.y = pk_f16(fast_tanh(f16lo(zw.y)), fast_tanh(f16hi(zw.y))); *(LAS u32x2*)(SAw + SA_WD + o8) = w; } \
            *(LAS u32x2*)(SAw + SA_AD + o8) = za; \
            if ((nA) >= NT / 2) { \
                const u32x2 g0 = pre_mix<LAT>(PX, 5, MUV(5), vA), g1 = pre_mix<LAT>(PX, 6, MUV(6), vA); \
                u32x2 w; w.x = pk_f16(fast_sigmoid(f16lo(g0.x)), fast_sigmoid(f16hi(g0.x))); w.y = pk_f16(fast_sigmoid(f16lo(g0.y)), fast_sigmoid(f16hi(g0.y))); *(LAS u32x2*)(SAw + SA_GD + (sA * GD_LD + 4 * gA) * 2) = w; \
                w.x = pk_f16(fast_sigmoid(f16lo(g1.x)), fast_sigmoid(f16hi(g1.x))); w.y = pk_f16(fast_sigmoid(f16lo(g1.y)), fast_sigmoid(f16hi(g1.y))); *(LAS u32x2*)(SAw + SA_GD + (sA * GD_LD + 64 + 4 * gA) * 2) = w; \
            } } while (0)
#define FINALIZE(nF) do { const bool finp = ((nF) >= NT / 2); const int cp = d ? NT - 1 - (nF) : (nF); const int pb = (nF) & 1; const int v3 = (nF) % 3; \
            const size_t row = row_base + (size_t)(16 * cp + (d ? 15 - sA : sA)); \
            const f32x4 yv = *(const LAS f32x4*)(Ld + L_YO + (sA * 68 + 4 * gA) * 4); \
            LAS unsigned char* bp = Ld + L_BONP + pb * 256; \
            const float bon = *(LAS float*)(bp + (0 * 16 + sA) * 4) + *(LAS float*)(bp + (1 * 16 + sA) * 4) + *(LAS float*)(bp + (2 * 16 + sA) * 4) + *(LAS float*)(bp + (3 * 16 + sA) * 4); \
            unsigned long long* yp = (unsigned long long*)(YA + row * D + chA); \
            if (!finp) { const unsigned long long w = (unsigned long long)pk_f16(yv[0], yv[1]) | ((unsigned long long)pk_f16(yv[2], yv[3]) << 32); \
                __hip_atomic_store(yp, w, __ATOMIC_RELAXED, __HIP_MEMORY_SCOPE_AGENT); if (gA == 0) __hip_atomic_store(BONG + row * 16 + h, bon, __ATOMIC_RELAXED, __HIP_MEMORY_SCOPE_AGENT); } \
            else { \
                const f32x4 y = {yv[0] + f16lo(yprev.x), yv[1] + f16hi(yprev.x), yv[2] + f16lo(yprev.y), yv[3] + f16hi(yprev.y)}; \
                const float mean = red16((y[0] + y[1]) + (y[2] + y[3])) * (1.0f / 64.0f); const f32x4 dv = y - mean; \
                const float var = red16((dv[0] * dv[0] + dv[1] * dv[1]) + (dv[2] * dv[2] + dv[3] * dv[3])) * (1.0f / 64.0f); \
                const f32x4 yn = dv * __builtin_amdgcn_rsqf(var + GN_EPS) * lng4 + lnb4; \
                const u32x2 vw = *(const LAS u32x2*)(Ld + L_VS + v3 * 2304 + (sA * HLD + 4 * gA) * 2); const f32x4 vv = {f16lo(vw.x), f16hi(vw.x), f16lo(vw.y), f16hi(vw.y)}; \
                const f32x4 gg = *(const LAS f32x4*)(Ld + L_GF + pb * 4352 + (sA * 68 + 4 * gA) * 4); \
                const f32x4 o = (yn + (bon + bgprev) * vv) * gg; \
                u32x2 w; w.x = pk_f16(o[0], o[1]); w.y = pk_f16(o[2], o[3]); *(u32x2*)yp = w; \
            } } while (0)

    if (helper) {
        pre_issue<LAT>(PA, Zr, row_base, d ? NT - 1 : 0, d, h, tg, NT / 2 <= 0);
        pre_issue<LAT>(PB, Zr, row_base, d ? NT - 2 : 1, d, h, tg, NT / 2 <= 1);
        STAGE_A(0, PA);
        pre_issue<LAT>(PA, Zr, row_base, d ? NT - 3 : 2, d, h, tg, NT / 2 <= 2);
        bool have_prev = false;
        __syncthreads();
#pragma unroll 1
        for (int n2_ = 0; n2_ < NT / 2; ++n2_) {
            int n2 = n2_; asm volatile("" : "+v"(n2)); n2 = __builtin_amdgcn_readfirstlane(n2);
#pragma unroll
        for (int par_ = 0; par_ < 2; ++par_) {
            const int n = 2 * n2 + par_;
            if (tid == 256 && n == NT / 2 + 1) __hip_atomic_store(flag_mine, (unsigned)(NT / 2), __ATOMIC_RELAXED, __HIP_MEMORY_SCOPE_AGENT);
            if (n + 1 < NT) { if (par_ == 0) STAGE_A(n + 1, PB); else STAGE_A(n + 1, PA); }
            __syncthreads();
            if (n > 0) {
                if (n - 1 >= NT / 2 && !have_prev) {
                    const int mP = n - 1;
                    if (!flag_ok) { unsigned spins = 0; while (__hip_atomic_load(flag_partner, __ATOMIC_RELAXED, __HIP_MEMORY_SCOPE_AGENT) < (unsigned)(NT / 2)) { __builtin_amdgcn_s_sleep(4); if (++spins > (1u << 22)) break; }
                        __builtin_amdgcn_fence(__ATOMIC_ACQUIRE, "agent"); flag_ok = true; }
                    const size_t rowp_ = row_base + (size_t)(16 * (d ? NT - 1 - mP : mP) + (d ? 15 - sA : sA));
                    const unsigned long long wq_ = __hip_atomic_load((const unsigned long long*)(YA + rowp_ * D + chA), __ATOMIC_RELAXED, __HIP_MEMORY_SCOPE_AGENT);
                    yprev.x = (unsigned)wq_; yprev.y = (unsigned)(wq_ >> 32);
                    bgprev = __hip_atomic_load(BONG + rowp_ * 16 + h, __ATOMIC_RELAXED, __HIP_MEMORY_SCOPE_AGENT);
                }
                FINALIZE(n - 1);
                if (n == NT / 2) asm volatile("s_waitcnt vmcnt(0)" ::: "memory");
            }
            have_prev = false;
            if (n >= NT / 2 && flag_ok) {
                    const int mP = n;
                    const size_t rowp_ = row_base + (size_t)(16 * (d ? NT - 1 - mP : mP) + (d ? 15 - sA : sA));
                    const unsigned long long wq_ = __hip_atomic_load((const unsigned long long*)(YA + rowp_ * D + chA), __ATOMIC_RELAXED, __HIP_MEMORY_SCOPE_AGENT);
                    yprev.x = (unsigned)wq_; yprev.y = (unsigned)(wq_ >> 32);
                    bgprev = __hip_atomic_load(BONG + rowp_ * 16 + h, __ATOMIC_RELAXED, __HIP_MEMORY_SCOPE_AGENT);
                    have_prev = true; }
            asm volatile("" ::: "memory");
            if (LAT && mid_cnt != nullptr && (n + 3 == 28 || n + 3 == 60)) {
                const unsigned* cw = mid_cnt + (n + 3 == 60 ? 64 : 0);
                unsigned spins = 0; while (__hip_atomic_load(cw, __ATOMIC_RELAXED, __HIP_MEMORY_SCOPE_AGENT) < 128u) { __builtin_amdgcn_s_sleep(8); if (++spins > (1u << 22)) break; }
                __builtin_amdgcn_fence(__ATOMIC_ACQUIRE, "agent"); }
            { const int nn = (n + 3 < NT) ? n + 3 : NT - 1;
              if (par_ == 0) pre_issue<LAT>(PB, Zr, row_base, d ? NT - 1 - nn : nn, d, h, tg, nn >= NT / 2); else pre_issue<LAT>(PA, Zr, row_base, d ? NT - 1 - nn : nn, d, h, tg, nn >= NT / 2); }
            __syncthreads();
        }
        }
        __syncthreads();
        if (!have_prev) {
                    const int mP = NT - 1;
                    if (!flag_ok) { unsigned spins = 0; while (__hip_atomic_load(flag_partner, __ATOMIC_RELAXED, __HIP_MEMORY_SCOPE_AGENT) < (unsigned)(NT / 2)) { __builtin_amdgcn_s_sleep(4); if (++spins > (1u << 22)) break; }
                        __builtin_amdgcn_fence(__ATOMIC_ACQUIRE, "agent"); flag_ok = true; }
                    const size_t rowp_ = row_base + (size_t)(16 * (d ? NT - 1 - mP : mP) + (d ? 15 - sA : sA));
                    const unsigned long long wq_ = __hip_atomic_load((const unsigned long long*)(YA + rowp_ * D + chA), __ATOMIC_RELAXED, __HIP_MEMORY_SCOPE_AGENT);
                    yprev.x = (unsigned)wq_; yprev.y = (unsigned)(wq_ >> 32);
                    bgprev = __hip_atomic_load(BONG + rowp_ * 16 + h, __ATOMIC_RELAXED, __HIP_MEMORY_SCOPE_AGENT);
        }
        FINALIZE(NT - 1);
    } else {
        __builtin_amdgcn_s_setprio(3);
        f16x8 wupB[2], aupB[2], gupB[4];
#pragma unroll
        for (int ks = 0; ks < 2; ++ks) { wupB[ks] = *(const f16x8*)(wu + 32 * ks); aupB[ks] = *(const f16x8*)(au + 32 * ks); }
#pragma unroll
        for (int ks = 0; ks < 4; ++ks) gupB[ks] = *(const f16x8*)(gu + 32 * ks);
        const float w0v = *w0p, a0v = *a0p, kac = *kap, rkc = *rkp;
        __syncthreads();
#pragma unroll 1
        for (int n_ = 0; n_ < NT; ++n_) {
            int n = n_; asm volatile("" : "+v"(n)); n = __builtin_amdgcn_readfirstlane(n);
            const bool fin = (n >= NT / 2);
            const int pbn = n & 1, v3n = n % 3;
            LAS unsigned char* SAb = Ld + L_SA + pbn * SA_SZ;
            {
            const int pbm = (n + 1) & 1, v3m = (n + 2) % 3;
            f16x8 sb[2];
#pragma unroll
            for (int ks = 0; ks < 2; ++ks) { u32x4 w; w.x = pk_f16(S[8 * ks], S[8 * ks + 1]); w.y = pk_f16(S[8 * ks + 2], S[8 * ks + 3]); w.z = pk_f16(S[8 * ks + 4], S[8 * ks + 5]); w.w = pk_f16(S[8 * ks + 6], S[8 * ks + 7]); sb[ks] = __builtin_bit_cast(f16x8, w); }
            const int il = 16 * q + c16;
            f32x4 U = *(const LAS f32x4*)(Ld + L_UVT + (il * TLD + 4 * g4) * 4);
            f32x4 Y = {0.f, 0.f, 0.f, 0.f};
            const int oa = (c16 * HLD + 8 * g4) * 2;
#pragma unroll
            for (int ks = 0; ks < 2; ++ks) {
                const f16x8 fap = *(const LAS f16x8*)(Ld + L_APR + oa + 64 * ks), fr0 = *(const LAS f16x8*)(Ld + L_R0 + pbm * 2304 + oa + 64 * ks);
                U = __builtin_amdgcn_mfma_f32_16x16x32_f16(fap, sb[ks], U, 0, 0, 0);
                Y = __builtin_amdgcn_mfma_f32_16x16x32_f16(fr0, sb[ks], Y, 0, 0, 0);
            }
            f16x8 uvb; { const u32x2 wv_ = *(const LAS u32x2*)(Ld + L_VT + v3m * 2560 + (il * TLD + 4 * g4) * 2); const u32x4 w4 = {pk_f16(U[0], U[1]), pk_f16(U[2], U[3]), wv_.x, wv_.y}; uvb = __builtin_bit_cast(f16x8, w4); }
            { const f16x8 fark = *(const LAS f16x8*)(Ld + L_ARK + (c16 * 40 + 8 * g4) * 2); Y = __builtin_amdgcn_mfma_f32_16x16x32_f16(fark, uvb, Y, 0, 0, 0); }
#pragma unroll
            for (int r = 0; r < 4; ++r) *(LAS float*)(Ld + L_YO + ((4 * g4 + r) * 68 + il) * 4) = Y[r];
#pragma unroll
            for (int jt = 0; jt < 4; ++jt) {
                const int jo = 32 * (jt >> 1) + 8 * (c16 >> 2) + 4 * (jt & 1) + (c16 & 3);
                const f16x8 fbk = *(const LAS f16x8*)(Ld + L_BKT + pbm * 5120 + (jo * 40 + 8 * g4) * 2);
                const f32x4 ec = *(const LAS f32x4*)(Ld + L_EC + pbm * 256 + (32 * (jt >> 1) + 8 * g4 + 4 * (jt & 1)) * 4);
                const int sbase = 8 * (jt >> 1) + 4 * (jt & 1);
                f32x4 cin = {S[sbase] * ec[0], S[sbase + 1] * ec[1], S[sbase + 2] * ec[2], S[sbase + 3] * ec[3]};
                cin = __builtin_amdgcn_mfma_f32_16x16x32_f16(fbk, uvb, cin, 0, 0, 0);
                S[sbase] = cin[0]; S[sbase + 1] = cin[1]; S[sbase + 2] = cin[2]; S[sbase + 3] = cin[3];
            }
            }
            {
            f32x4 cw = {0.f, 0.f, 0.f, 0.f}, ca = {0.f, 0.f, 0.f, 0.f};
#pragma unroll
            for (int ks = 0; ks < 2; ++ks) {
                const f16x8 fw = *(const LAS f16x8*)(SAb + SA_WD + (c16 * HLD + kq + 32 * ks) * 2);
                const f16x8 fa = *(const LAS f16x8*)(SAb + SA_AD + (c16 * HLD + kq + 32 * ks) * 2);
                cw = __builtin_amdgcn_mfma_f32_16x16x32_f16(fw, wupB[ks], cw, 0, 0, 0);
                ca = __builtin_amdgcn_mfma_f32_16x16x32_f16(fa, aupB[ks], ca, 0, 0, 0);
            }
            if (fin) {
                f32x4 cg_ = {0.f, 0.f, 0.f, 0.f};
#pragma unroll
                for (int ks = 0; ks < 4; ++ks) { const f16x8 fg = *(const LAS f16x8*)(SAb + SA_GD + (c16 * GD_LD + kq + 32 * ks) * 2); cg_ = __builtin_amdgcn_mfma_f32_16x16x32_f16(fg, gupB[ks], cg_, 0, 0, 0); }
#pragma unroll
                for (int r = 0; r < 4; ++r) *(LAS float*)(Ld + L_GF + pbn * 4352 + ((4 * g4 + r) * 68 + jl) * 4) = cg_[r];
            }
            float wv[4], av[4], rr[4], kd[4], kn[4];
#pragma unroll
            for (int r = 0; r < 4; ++r) { const int o = ((4 * g4 + r) * HLD + jl) * 2;
                wv[r] = __expf(-DECAY_SCALE * fast_sigmoid(w0v + cw[r])); av[r] = fast_sigmoid(a0v + ca[r]);
                rr[r] = (float)*(LAS f16*)(SAb + SA_RH + o); const float kr = (float)*(LAS f16*)(SAb + SA_KRH + o); kn[r] = (float)*(LAS f16*)(SAb + SA_KNH + o);
                kd[r] = kr * (1.0f + (av[r] - 1.0f) * kac); }
            float E[4]; E[0] = wv[0]; E[1] = E[0] * wv[1]; E[2] = E[1] * wv[2]; E[3] = E[2] * wv[3];
            float tt = E[3];
            { const float u1 = __shfl_up(tt, 16); if (g4 >= 1) tt *= u1; const float u2 = __shfl_up(tt, 32); if (g4 >= 2) tt *= u2; }
            float ex = __shfl_up(tt, 16); if (g4 == 0) ex = 1.0f;
            const float EC = __shfl(tt, 48 + c16), Emid = __shfl(tt, 16 + c16);
            const float c1 = __builtin_amdgcn_rcpf(Emid), c2 = Emid;
            float bonp[4]; float a0t[4]; unsigned short hBp[4], hKp[4];
#pragma unroll
            for (int r = 0; r < 4; ++r) {
                const float Ei = ex * E[r], Ep = (r == 0) ? ex : ex * E[r - 1], inv = __builtin_amdgcn_rcpf(Ei);
                const float aa = -kn[r], bb = av[r] * kn[r];
                a0t[r] = aa * Ep;
                hBp[r] = __builtin_bit_cast(unsigned short, (f16)(bb * inv * EC)); hKp[r] = __builtin_bit_cast(unsigned short, (f16)(kd[r] * inv * EC));
                bonp[r] = red16(kd[r] * rkc * rr[r]);
                const int o = ((4 * g4 + r) * HLD + jl) * 2;
                *(LAS f16*)(Ld + L_AREF + o) = (f16)(a0t[r] * c1); *(LAS f16*)(Ld + L_RREF + o) = (f16)(rr[r] * Ei * c1); *(LAS f16*)(Ld + L_BREF + o) = (f16)(bb * inv * c2); *(LAS f16*)(Ld + L_KREF + o) = (f16)(kd[r] * inv * c2);
                *(LAS f16*)(Ld + L_R0 + pbn * 2304 + o) = (f16)(rr[r] * Ei);
            }
            *(LAS f32x4*)(Ld + L_A0T + (jl * TLD + 4 * g4) * 4) = (f32x4){a0t[0], a0t[1], a0t[2], a0t[3]};
            { u32x4 w; w.x = hBp[0] | ((unsigned)hBp[1] << 16); w.y = hBp[2] | ((unsigned)hBp[3] << 16); w.z = hKp[0] | ((unsigned)hKp[1] << 16); w.w = hKp[2] | ((unsigned)hKp[3] << 16);
              *(LAS u32x4*)(Ld + L_BKT + pbn * 5120 + (jl * 40 + 8 * g4) * 2) = w; }
            if (g4 == 0) *(LAS float*)(Ld + L_EC + pbn * 256 + jl * 4) = EC;
            if (c16 == 0) {
#pragma unroll
                for (int r = 0; r < 4; ++r) *(LAS float*)(Ld + L_BONP + pbn * 256 + (q * 16 + 4 * g4 + r) * 4) = bonp[r]; }
            }
            __syncthreads();
            {
            if (q == 0) {
                const f32x4 ab = tile_xyT(Ld + L_AREF, Ld + L_BREF, lane);
#pragma unroll
                for (int r = 0; r < 4; ++r) *(LAS float*)(Ld + L_AAB + ((4 * g4 + r) * 16 + c16) * 4) = ab[r];
                float x[16], arow[16];
#pragma unroll
                for (int t4 = 0; t4 < 4; ++t4) { const f32x4 v = *(const LAS f32x4*)(Ld + L_A0T + (lane * TLD + 4 * t4) * 4); x[4 * t4] = v[0]; x[4 * t4 + 1] = v[1]; x[4 * t4 + 2] = v[2]; x[4 * t4 + 3] = v[3]; }
#pragma unroll
                for (int t = 0; t < 16; ++t) arow[t] = *(LAS float*)(Ld + L_AAB + (t * 16 + c16) * 4);
                fwd_subst(x, arow);
#pragma unroll
                for (int t = 0; t < 16; ++t) *(LAS f16*)(Ld + L_APR + (t * HLD + lane) * 2) = (f16)x[t];
            } else if (q == 1) {
                const f32x4 ab = tile_xyT(Ld + L_AREF, Ld + L_BREF, lane);
                const f32x4 ak = tile_xyT(Ld + L_AREF, Ld + L_KREF, lane);
#pragma unroll
                for (int r = 0; r < 4; ++r) { const int t = 4 * g4 + r; *(LAS float*)(Ld + L_AAB + 1024 + (t * 16 + c16) * 4) = ab[r]; *(LAS f16*)(Ld + L_AAK + (t * 16 + c16) * 2) = (f16)((c16 < t) ? ak[r] : 0.f); }
                f16x8 fa; { const u32x2 w = *(const LAS u32x2*)(Ld + L_AAK + (c16 * 16 + 4 * g4) * 2); const u32x4 w4 = {w.x, w.y, 0u, 0u}; fa = __builtin_bit_cast(f16x8, w4); }
#pragma unroll
                for (int it = 0; it < 4; ++it) {
                    const u32x2 wv_ = *(const LAS u32x2*)(Ld + L_VT + v3n * 2560 + ((16 * it + c16) * TLD + 4 * g4) * 2); const u32x4 w4 = {wv_.x, wv_.y, 0u, 0u};
                    f32x4 acc = {0.f, 0.f, 0.f, 0.f};
                    acc = __builtin_amdgcn_mfma_f32_16x16x32_f16(fa, __builtin_bit_cast(f16x8, w4), acc, 0, 0, 0);
                    *(LAS f32x4*)(Ld + L_UVT + ((16 * it + c16) * TLD + 4 * g4) * 4) = acc;
                }
                float x[16], arow[16];
#pragma unroll
                for (int t4 = 0; t4 < 4; ++t4) { const f32x4 v = *(const LAS f32x4*)(Ld + L_UVT + (lane * TLD + 4 * t4) * 4); x[4 * t4] = v[0]; x[4 * t4 + 1] = v[1]; x[4 * t4 + 2] = v[2]; x[4 * t4 + 3] = v[3]; }
#pragma unroll
                for (int t = 0; t < 16; ++t) arow[t] = *(LAS float*)(Ld + L_AAB + 1024 + (t * 16 + c16) * 4);
                fwd_subst(x, arow);
#pragma unroll
                for (int t4 = 0; t4 < 4; ++t4) *(LAS f32x4*)(Ld + L_UVT + (lane * TLD + 4 * t4) * 4) = (f32x4){x[4 * t4], x[4 * t4 + 1], x[4 * t4 + 2], x[4 * t4 + 3]};
            } else if (q == 2) {
                const f32x4 rb = tile_xyT(Ld + L_RREF, Ld + L_BREF, lane);
                const f32x4 rk = tile_xyT(Ld + L_RREF, Ld + L_KREF, lane);
#pragma unroll
                for (int r = 0; r < 4; ++r) { const int t = 4 * g4 + r; const bool keep = (c16 <= t);
                    *(LAS f16*)(Ld + L_ARK + (t * 40 + 8 * (c16 >> 2) + (c16 & 3)) * 2) = (f16)(keep ? rb[r] : 0.f);
                    *(LAS f16*)(Ld + L_ARK + (t * 40 + 8 * (c16 >> 2) + 4 + (c16 & 3)) * 2) = (f16)(keep ? rk[r] : 0.f); }
            }
            }
            __syncthreads();
        }
        {
            const int n = NT; const int pbn = n & 1; (void)pbn;
            const int pbm = (n - 1) & 1, v3m = (n - 1) % 3;
            f16x8 sb[2];
#pragma unroll
            for (int ks = 0; ks < 2; ++ks) { u32x4 w; w.x = pk_f16(S[8 * ks], S[8 * ks + 1]); w.y = pk_f16(S[8 * ks + 2], S[8 * ks + 3]); w.z = pk_f16(S[8 * ks + 4], S[8 * ks + 5]); w.w = pk_f16(S[8 * ks + 6], S[8 * ks + 7]); sb[ks] = __builtin_bit_cast(f16x8, w); }
            const int il = 16 * q + c16;
            f32x4 U = *(const LAS f32x4*)(Ld + L_UVT + (il * TLD + 4 * g4) * 4);
            f32x4 Y = {0.f, 0.f, 0.f, 0.f};
            const int oa = (c16 * HLD + 8 * g4) * 2;
#pragma unroll
            for (int ks = 0; ks < 2; ++ks) {
                const f16x8 fap = *(const LAS f16x8*)(Ld + L_APR + oa + 64 * ks), fr0 = *(const LAS f16x8*)(Ld + L_R0 + pbm * 2304 + oa + 64 * ks);
                U = __builtin_amdgcn_mfma_f32_16x16x32_f16(fap, sb[ks], U, 0, 0, 0);
                Y = __builtin_amdgcn_mfma_f32_16x16x32_f16(fr0, sb[ks], Y, 0, 0, 0);
            }
            f16x8 uvb; { const u32x2 wv_ = *(const LAS u32x2*)(Ld + L_VT + v3m * 2560 + (il * TLD + 4 * g4) * 2); const u32x4 w4 = {pk_f16(U[0], U[1]), pk_f16(U[2], U[3]), wv_.x, wv_.y}; uvb = __builtin_bit_cast(f16x8, w4); }
            { const f16x8 fark = *(const LAS f16x8*)(Ld + L_ARK + (c16 * 40 + 8 * g4) * 2); Y = __builtin_amdgcn_mfma_f32_16x16x32_f16(fark, uvb, Y, 0, 0, 0); }
#pragma unroll
            for (int r = 0; r < 4; ++r) *(LAS float*)(Ld + L_YO + ((4 * g4 + r) * 68 + il) * 4) = Y[r];
#pragma unroll
            for (int jt = 0; jt < 4; ++jt) {
                const int jo = 32 * (jt >> 1) + 8 * (c16 >> 2) + 4 * (jt & 1) + (c16 & 3);
                const f16x8 fbk = *(const LAS f16x8*)(Ld + L_BKT + pbm * 5120 + (jo * 40 + 8 * g4) * 2);
                const f32x4 ec = *(const LAS f32x4*)(Ld + L_EC + pbm * 256 + (32 * (jt >> 1) + 8 * g4 + 4 * (jt & 1)) * 4);
                const int sbase = 8 * (jt >> 1) + 4 * (jt & 1);
                f32x4 cin = {S[sbase] * ec[0], S[sbase + 1] * ec[1], S[sbase + 2] * ec[2], S[sbase + 3] * ec[3]};
                cin = __builtin_amdgcn_mfma_f32_16x16x32_f16(fbk, uvb, cin, 0, 0, 0);
                S[sbase] = cin[0]; S[sbase + 1] = cin[1]; S[sbase + 2] = cin[2]; S[sbase + 3] = cin[3];
            }
        }
        __builtin_amdgcn_s_setprio(0);
        __syncthreads();
        if (!LAT) { float* sp = a.out + (size_t)M * D + sidx;
#pragma unroll
            for (int n = 0; n < 16; ++n) sp[perm_o(32 * (n >> 3) + 8 * g4 + (n & 7))] = S[n]; }
    }
    __syncthreads();
#undef STAGE_A
#undef FINALIZE
#undef MUV
}
__device__ __forceinline__ void scan_phase(const Args& a, int z, int l, LAS unsigned char* lds, int G, int bx, int tid, int wave, int lane, const unsigned* mid_cnt = nullptr) {
    if (G == 256) {
        const int d = (bx >> 3) & 1, p = (bx & 7) + 8 * (bx >> 4);
        if (p < 64) scan_chain<true>(a, z, l, lds, p, p >> 4, p & 15, d, tid, wave, lane, mid_cnt);
        else for (int u = p - 64; u < 512; u += 64) scan_chain<false>(a, z, l, lds, 64 + u, u >> 4, u & 15, d, tid, wave, lane);
    } else {
        const int d = bx & 1, np = G >> 1;
        if (bx < 2 * np) for (int u = bx >> 1; u < 576; u += np) { if (u < 64) scan_chain<true>(a, z, l, lds, u, u >> 4, u & 15, d, tid, wave, lane); else scan_chain<false>(a, z, l, lds, u, (u - 64) >> 4, (u - 64) & 15, d, tid, wave, lane); }
    }
}

constexpr int MX_LD = 272, MX_TB = 128 * MX_LD, MX_STAT = 2 * MX_TB;
__device__ __forceinline__ f16x4 tr_read(LAS unsigned char* p) { return __builtin_bit_cast(f16x4, __builtin_amdgcn_ds_read_tr16_b64_v4i16((LAS v4i16_t*)p)); }
__device__ __forceinline__ void mix_phase(const Args& a, int z, int l, LAS unsigned char* lds, int G, int bx, int tid, int wave, int lane) {
    f16* U16 = (f16*)(a.ws + WS_BIG + 48 * MiB); const f16* V16 = (const f16*)(a.ws + WS_BIG + 96 * MiB);
    const f16* ws16 = (const f16*)(a.ws + WS_SMALL + SM_WS) + (size_t)l * 8 * 128 * 128;
    const float* lnvg = a.in[z + I_LNVG] + l * 1024; const float* bs = a.in[z + I_BS] + l * 1024;
    LAS float* STAT = (LAS float*)(lds + MX_STAT);
    const int pl = 16 * wave + (lane & 15), g4 = lane >> 4;
    for (int unit = bx; unit < M / 128; unit += G) {
        const size_t r0 = (size_t)unit * 128;
        {
            f16x8 x[4][8];
#pragma unroll
            for (int ps = 0; ps < 4; ++ps) { const f16* p = V16 + (r0 + 16 * wave + 4 * ps + g4) * D + 8 * (lane & 15);
#pragma unroll
                for (int k = 0; k < 8; ++k) x[ps][k] = *(const f16x8*)(p + 128 * k); }
#pragma unroll
            for (int ps = 0; ps < 4; ++ps) { const int q = 16 * wave + 4 * ps + g4;
                float s = 0.f, s2 = 0.f;
#pragma unroll
                for (int k = 0; k < 8; ++k)
#pragma unroll
                    for (int e = 0; e < 8; ++e) { const float v = (float)x[ps][k][e]; s += v; s2 += v * v; }
                s = red16(s); s2 = red16(s2);
                const float mean = s * (1.0f / D); const float var = s2 * (1.0f / D) - mean * mean;
                if ((lane & 15) == 0) { STAT[2 * q] = mean; STAT[2 * q + 1] = __builtin_amdgcn_rsqf((var > 0.f ? var : 0.f) + EPS); } }
        }
        const int qs = tid >> 4, ch = tid & 15;
        f16x8 vreg[4]; u32x2 ureg[8]; f16x8 wfrag[4]; f32x4 gpre0, gpre1;
#define MIX_PREFETCH(hh) do { \
            _Pragma("unroll") for (int i = 0; i < 4; ++i) vreg[i] = *(const f16x8*)(V16 + (r0 + qs + 32 * i) * D + (hh) * 128 + 8 * ch); \
            _Pragma("unroll") for (int ct = 0; ct < 8; ++ct) ureg[ct] = *(const u32x2*)(U16 + (r0 + pl) * D + (hh) * 128 + 16 * ct + 4 * g4); \
            _Pragma("unroll") for (int ks = 0; ks < 4; ++ks) wfrag[ks] = *(const f16x8*)(ws16 + ((size_t)((hh) * 128 + pl)) * 128 + 32 * ks + 8 * g4); \
            gpre0 = *(const f32x4*)(lnvg + (hh) * 128 + 8 * ch); gpre1 = *(const f32x4*)(lnvg + (hh) * 128 + 8 * ch + 4); } while (0)
        MIX_PREFETCH(0);
        __syncthreads();
#pragma unroll 1
        for (int h = 0; h < 8; ++h) {
            LAS unsigned char* T = lds + (h & 1) * MX_TB;
            { const f32x4 g0 = gpre0, g1 = gpre1;
#pragma unroll
              for (int i = 0; i < 4; ++i) { const int q = qs + 32 * i; const float mean = STAT[2 * q], rstd = STAT[2 * q + 1]; const f16x8 x = vreg[i];
                u32x4 w; w.x = pk_f16(((float)x[0] - mean) * rstd * g0[0], ((float)x[1] - mean) * rstd * g0[1]); w.y = pk_f16(((float)x[2] - mean) * rstd * g0[2], ((float)x[3] - mean) * rstd * g0[3]);
                w.z = pk_f16(((float)x[4] - mean) * rstd * g1[0], ((float)x[5] - mean) * rstd * g1[1]); w.w = pk_f16(((float)x[6] - mean) * rstd * g1[2], ((float)x[7] - mean) * rstd * g1[3]);
                *(LAS u32x4*)(T + q * MX_LD + ch * 16) = w; } }
            u32x2 ucur[8]; f16x8 wcur[4];
#pragma unroll
            for (int ct = 0; ct < 8; ++ct) ucur[ct] = ureg[ct];
#pragma unroll
            for (int ks = 0; ks < 4; ++ks) wcur[ks] = wfrag[ks];
            const float bsv = bs[h * 128 + pl];
            { const int hn = (h + 1 < 8) ? h + 1 : 7; MIX_PREFETCH(hn); }
            __syncthreads();
            LAS unsigned char* tb = T + (8 * g4 + ((lane & 15) >> 2)) * MX_LD + (4 * (lane & 3)) * 2;
#pragma unroll
            for (int ct = 0; ct < 8; ++ct) {
                f32x4 acc = {0.f, 0.f, 0.f, 0.f};
#pragma unroll
                for (int ks = 0; ks < 4; ++ks) {
                    const f16x4 v1 = tr_read(tb + (32 * ks) * MX_LD + ct * 32), v2 = tr_read(tb + (32 * ks + 4) * MX_LD + ct * 32);
                    const f16x8 vf = {v1[0], v1[1], v1[2], v1[3], v2[0], v2[1], v2[2], v2[3]};
                    acc = __builtin_amdgcn_mfma_f32_16x16x32_f16(vf, wcur[ks], acc, 0, 0, 0);
                }
                const u32x2 uu = ucur[ct];
                u32x2 o; o.x = pk_f16(f16lo(uu.x) * (acc[0] + bsv), f16hi(uu.x) * (acc[1] + bsv)); o.y = pk_f16(f16lo(uu.y) * (acc[2] + bsv), f16hi(uu.y) * (acc[3] + bsv));
                *(u32x2*)(U16 + (r0 + pl) * D + h * 128 + 16 * ct + 4 * g4) = o;
            }
        }
#undef MIX_PREFETCH
        __syncthreads();
    }
}

constexpr int CW_BAR = 65536;
constexpr int LDSCTL_OFF = 131072 + 8192;
#define XB_TMO      128
#define XB_XCNT(j)  (256  + 64 * (j))
#define XB_XSUB(j)  (1280 + 64 * (j))
#define XB_XGEN(j)  (2304 + 64 * (j))
#define XB_TOP      3328
#define XB_TOPGEN   3392
#define XCD_BAR_WORDS 3456
#define XB_SPIN_CAP (1u << 18)

__device__ __forceinline__ unsigned xb_ld(unsigned* p)              { return __hip_atomic_load(p, __ATOMIC_RELAXED, __HIP_MEMORY_SCOPE_AGENT); }
__device__ __forceinline__ unsigned xb_add(unsigned* p, unsigned v) { return __hip_atomic_fetch_add(p, v, __ATOMIC_RELAXED, __HIP_MEMORY_SCOPE_AGENT); }
__device__ __forceinline__ unsigned xb_xcc_id() { return (unsigned)__builtin_amdgcn_s_getreg((3 << 11) | 20) & 0xFu; }
#define XB_SPIN(cond, bar) do { unsigned _sp = 0; while (cond) { __builtin_amdgcn_s_sleep(1); \
    if ((++_sp & 255u) == 0u) { if (xb_ld(&(bar)[XB_TMO])) break; if (_sp > XB_SPIN_CAP) { atomicAdd(&(bar)[XB_TMO], 1u); break; } } } } while (0)

struct XcdBarrier {
    unsigned* bar; unsigned x;
    volatile LAS unsigned* st;
};

__device__ __forceinline__ XcdBarrier xcd_barrier_post(unsigned* bar, volatile LAS unsigned* st) {
    XcdBarrier b; b.bar = bar; b.x = xb_xcc_id(); b.st = st;
    if (threadIdx.x == 0) (void)xb_add(&bar[XB_XCNT(b.x)], 1u);
    return b;
}
__device__ __forceinline__ void xcd_barrier_complete(unsigned* bar, unsigned x, unsigned& nloc, unsigned& nx) {
    const unsigned G = gridDim.x * gridDim.y * gridDim.z;
    unsigned sum, cnt, mine, sp = 0u;
    for (;;) {
        sum = 0u; cnt = 0u; mine = 0u;
#pragma unroll
        for (unsigned j = 0; j < 16; ++j) { const unsigned c = xb_ld(&bar[XB_XCNT(j)]); sum += c; cnt += (c > 0u) ? 1u : 0u; mine = (j == x) ? c : mine; }
        if (sum == G) break;
        __builtin_amdgcn_s_sleep(1);
        if ((++sp & 255u) == 0u) { if (xb_ld(&bar[XB_TMO])) break; if (sp > XB_SPIN_CAP) { atomicAdd(&bar[XB_TMO], 1u); break; } }
    }
    nloc = mine > 0u ? mine : 1u; nx = cnt > 0u ? cnt : 1u;
}

__device__ __forceinline__ void xcd_barrier(const XcdBarrier& b) {
    asm volatile("s_waitcnt vmcnt(0)" ::: "memory");
    __syncthreads();
    if (threadIdx.x == 0) {
        unsigned* bar = b.bar;
        __builtin_amdgcn_s_waitcnt(0);
        unsigned nloc = b.st[0], nx = b.st[1];
        if (nloc == 0u) { xcd_barrier_complete(bar, b.x, nloc, nx); b.st[0] = nloc; b.st[1] = nx; }
        const unsigned old = xb_add(&bar[XB_XSUB(b.x)], 1u);
        const unsigned gen = old / nloc;
        if (old + 1u == (gen + 1u) * nloc) {
            __builtin_amdgcn_fence(__ATOMIC_RELEASE, "agent");
            asm volatile("s_waitcnt vmcnt(0)" ::: "memory");
            const unsigned og = xb_add(&bar[XB_TOP], 1u);
            const unsigned tg = og / nx;
            if (og + 1u == (tg + 1u) * nx) xb_add(&bar[XB_TOPGEN], 1u);
            else XB_SPIN(xb_ld(&bar[XB_TOPGEN]) == tg, bar);
            __builtin_amdgcn_fence(__ATOMIC_ACQUIRE, "agent");
            xb_add(&bar[XB_XGEN(b.x)], 1u);
            asm volatile("s_waitcnt vmcnt(0)" ::: "memory");
        } else {
            XB_SPIN(xb_ld(&bar[XB_XGEN(b.x)]) == gen, bar);
            __builtin_amdgcn_fence(__ATOMIC_ACQUIRE, "agent");
            asm volatile("s_waitcnt vmcnt(0)" ::: "memory");
        }
    }
    __syncthreads();
}

#ifndef REP_P0
#define REP_P0 1
#endif
#ifndef REP_NORM
#define REP_NORM 1
#endif
#ifndef REP_SCAN
#define REP_SCAN 1
#endif
#ifndef REP_G1
#define REP_G1 1
#endif
#ifndef REP_G4
#define REP_G4 1
#endif
#ifndef REP_G7
#define REP_G7 1
#endif
#ifndef REP_G11
#define REP_G11 1
#endif
constexpr int PH_PER_LAYER = 14, NPHASES = 1 + NLAYER * PH_PER_LAYER + 1;
template <int ph> __device__ __forceinline__ void run_phase(const Args& a, LAS unsigned char* lds) {
    int tid = threadIdx.x; asm volatile("" : "+v"(tid));
    int bx = blockIdx.x; asm volatile("" : "+s"(bx));
    int G = gridDim.x; asm volatile("" : "+s"(G));
    int z = 0; asm volatile("" : "+s"(z));
    const int lane = tid & 63, wave = __builtin_amdgcn_readfirstlane(tid >> 6);
    const int gw = bx * NWAVES + wave, ngw = G * NWAVES;
    unsigned char* ws = a.ws;
    f16* W16 = (f16*)(ws + WS_W16);
    f16* RB = (f16*)(ws + WS_B);
    f16* BIG = (f16*)(ws + WS_BIG);
    f16* HB2 = BIG;
    f16* U16 = (f16*)(ws + WS_BIG + 48 * MiB);
    f16* G16 = (f16*)(ws + WS_BIG + 96 * MiB);
    float* X = a.out;
    const float* MOD = (const float*)(ws + WS_MOD);
    if (ph == 0) { for (int rep = 0; rep < REP_P0; ++rep) { p0_prologue(a, z, lds, G, bx, tid, wave, lane); __syncthreads(); } }
    else if (ph == NPHASES - 1) { final_norm_phase(X, a.in[z + I_FING], gw, ngw, lane); }
    else {
        constexpr int l = (ph - 1) / PH_PER_LAYER, k = (ph - 1) % PH_PER_LAYER;
        const float* modl = MOD + (size_t)l * 5 * 6144;
        float* xbuf = (float*)(ws + WS_BON + (size_t)M * 16 * 4); unsigned* ncnt = (unsigned*)(ws + WS_CTL) + 131072 + (size_t)(l * 2) * 96 * 64;
        constexpr bool x_in_out = (l > 0);
        const float* bc = x_in_out ? (const float*)X : a.in[z + I_XP];
        const float* bl = x_in_out ? (const float*)(X + (size_t)MCTX * D) : a.in[z + I_XS];
        if constexpr (k == 0) {
            if (l > 0) convert_layer_weights(a, z, l, lds, gw, ngw, wave, lane, bx * NTHR + tid, G * NTHR);
            if (l == 0 || G != 256) norm_phase(bc, bl, a.in[z + I_N1G] + l * D, modl, 0, 1, RB, gw, ngw, lane);
        } else if constexpr (k == 1) { pg8::Gemm g{RB, W16 + W_INR, M, ZRN, D}; pg8::EpiH16<0> E{BIG, ZRN, 0, 0};
            if (G == 256) { pg8::SeamOrder S; S.init(0, bx, nullptr); pg8::gemm_phase<pg8::EpiH16<0>, pg8::SeamOrder, true, true>(lds, g, S, E); }
            else { pg8::StaticOrder S; S.init(M, ZRN, G, bx); pg8::gemm_phase<pg8::EpiH16<0>, pg8::StaticOrder, true, true>(lds, g, S, E); }
        } else if constexpr (k == 2) {
            if (G == 256) {
                unsigned* c1 = (unsigned*)(ws + WS_CTL) + 49152 + l * 256; unsigned* c2 = c1 + 128;
                if (bx >= 128) {
                    pg8::Gemm g{RB, W16 + W_INR, M, ZRN, D}; pg8::EpiH16<0> E{BIG, ZRN, 0, 0}; pg8::SeamOrder S; S.init(1, bx - 128, c1);
                    pg8::gemm_phase<pg8::EpiH16<0>, pg8::SeamOrder, true, true>(lds, g, S, E);
                    asm volatile("s_waitcnt vmcnt(0)" ::: "memory"); __syncthreads();
                    if (tid == 0) { __builtin_amdgcn_fence(__ATOMIC_RELEASE, "agent"); asm volatile("s_waitcnt vmcnt(0)" ::: "memory"); (void)__hip_atomic_fetch_add(c2, 1u, __ATOMIC_RELAXED, __HIP_MEMORY_SCOPE_AGENT);
                        unsigned spins = 0; while (__hip_atomic_load(c2, __ATOMIC_RELAXED, __HIP_MEMORY_SCOPE_AGENT) < 128u) { __builtin_amdgcn_s_sleep(2); if (++spins > (1u << 24)) break; }
                        __builtin_amdgcn_fence(__ATOMIC_ACQUIRE, "agent"); asm volatile("s_waitcnt vmcnt(0)" ::: "memory"); }
                    __syncthreads();
                }
                scan_phase(a, z, l, lds, G, bx, tid, wave, lane, c1); __syncthreads();
            } else { scan_phase(a, z, l, lds, G, bx, tid, wave, lane); __syncthreads(); }
        } else if constexpr (k == 3) { if constexpr (l > 0) norm_phase(bc, bl, a.in[z + I_N1G] + l * D, modl, 0, 1, HB2, gw, ngw, lane);
        } else if constexpr (k == 4) { pg8::Gemm g{l == 0 ? RB : HB2, W16 + W_INUV, M, 2048, D}; pg8::StaticOrder S; S.init(M, 2048, G, bx); pg8::EpiH16<1> E{U16, D, 1024, (size_t)(48 * MiB / 2)};
            for (int rep = 0; rep < REP_G4; ++rep) pg8::gemm_phase<pg8::EpiH16<1>, pg8::StaticOrder, true, true>(lds, g, S, E);
        } else if constexpr (k == 5) { mix_phase(a, z, l, lds, G, bx, tid, wave, lane);
        } else if constexpr (k == 6) { pg8::Gemm g{l == 0 ? RB : HB2, W16 + W_ING, M, 2048, D}; pg8::StaticOrder S; S.init(M, 2048, G, bx); pg8::EpiH16<2> E{G16, 2048, 0, 0};
            pg8::gemm_phase<pg8::EpiH16<2>, pg8::StaticOrder, true, true>(lds, g, S, E);
        } else if constexpr (k == 7) { pg8::Gemm g7{l == 0 ? (const f16*)X : (const f16*)RB, W16 + W_A, M, D, D}; pg8::EpiMix<false> E7{HB2, G16, 0}; pg8::Gemm g8{U16, W16 + W_B, M, D, D}; pg8::EpiMix<true> E8{HB2, G16, 1024};
            if (G == 256) {
                if (bx < 128) { pg8::SubOrder S; S.init2(MCTX, D, 128, bx, 0, 0); pg8::gemm_phase<pg8::EpiMix<false>, pg8::SubOrder, true, true>(lds, g7, S, E7); pg8::gemm_phase<pg8::EpiMix<true>, pg8::SubOrder, true, true>(lds, g8, S, E8); }
                else { pg8::SubOrder S; S.init2(MLAT, D, 128, bx - 128, 32, 0); pg8::gemm_phase<pg8::EpiMix<false>, pg8::SubOrder, true, true>(lds, g7, S, E7); }
            } else { pg8::StaticOrder S; S.init(M, D, G, bx); pg8::gemm_phase<pg8::EpiMix<false>, pg8::StaticOrder, true, true>(lds, g7, S, E7); }
        } else if constexpr (k == 8) { pg8::Gemm g8{U16, W16 + W_B, M, D, D}; pg8::EpiMix<true> E8{HB2, G16, 1024};
            if (G == 256) {
                { pg8::SubOrder S; S.init2(MLAT, D, 256, bx, 32, 0); pg8::gemm_phase<pg8::EpiMix<true>, pg8::SubOrder, true, true>(lds, g8, S, E8); }
                if (bx < 128) { pg8::Gemm g9{HB2, W16 + W_OUT, M, D, D}; pg8::EpiResNorm<false> E9{bc, bl, X, modl + 2 * 1024, RB, a.in[z + I_N2G] + l * D, modl, 3, 4, xbuf, ncnt, EPS}; pg8::SubOrder S; S.init2(MCTX, D, 128, bx, 0, 0);
                    pg8::gemm_phase<pg8::EpiResNorm<false>, pg8::SubOrder, true, true>(lds, g9, S, E9); }
            } else { pg8::StaticOrder S; S.init(M, D, G, bx); pg8::gemm_phase<pg8::EpiMix<true>, pg8::StaticOrder, true, true>(lds, g8, S, E8); }
        } else if constexpr (k == 9) { pg8::Gemm g{HB2, W16 + W_OUT, M, D, D}; pg8::EpiRes E{bc, bl, X, modl + 2 * 1024};
            if (G == 256) { pg8::EpiResNorm<false> EN{bc, bl, X, modl + 2 * 1024, RB, a.in[z + I_N2G] + l * D, modl, 3, 4, xbuf, ncnt, EPS}; pg8::SubOrder S; S.init2(MLAT, D, 256, bx, 32, 0);
                pg8::gemm_phase<pg8::EpiResNorm<false>, pg8::SubOrder, true, true>(lds, g, S, EN); }
            else { pg8::StaticOrder S; S.init(M, D, G, bx); pg8::gemm_phase<pg8::EpiRes, pg8::StaticOrder, true, true>(lds, g, S, E); }
        } else if constexpr (k == 10) { norm_phase(X, X + (size_t)MCTX * D, a.in[z + I_N2G] + l * D, modl, 3, 4, RB, gw, ngw, lane);
        } else if constexpr (k == 11) { pg8::Gemm g{RB, W16 + W_1, M, DFF, D}; pg8::EpiH16<3> E{BIG, DFF, 0, 0};
            if (G == 256) { pg8::EpiH16B<3> EB{BIG, DFF}; pg8::SubOrder S; S.init2(MCTX, DFF, 256, bx, 0, 0); pg8::gemm_phase<pg8::EpiH16B<3>, pg8::SubOrder, true, true>(lds, g, S, EB); }
            else { pg8::StaticOrder S; S.init(M, DFF, G, bx); pg8::gemm_phase<pg8::EpiH16<3>, pg8::StaticOrder, true, true>(lds, g, S, E); }
        } else if constexpr (k == 12) {
            if (G == 256) {
                { pg8::Gemm g{RB, W16 + W_1, M, DFF, D}; pg8::EpiH16B<3> E{BIG, DFF}; pg8::SubOrder S; S.init2(MLAT, DFF, 256, bx, 32, bx < 128 ? 1 : 2); pg8::gemm_phase<pg8::EpiH16B<3>, pg8::SubOrder, true, true>(lds, g, S, E); }
                if (bx >= 128) { __syncthreads(); pg8::Gemm g{BIG, W16 + W_2, M, D, DFF}; pg8::SubOrder S; S.init2(MCTX, D, 128, bx - 128, 0, 0);
                    if constexpr (l + 1 < NLAYER) { pg8::EpiResNorm<false> E{X, X + (size_t)MCTX * D, X, modl + 5 * 1024, RB, a.in[z + I_N1G] + (l + 1) * D, MOD + (size_t)(l + 1) * 5 * 6144, 0, 1, xbuf, ncnt + 96 * 64, EPS};
                        pg8::gemm_phase<pg8::EpiResNorm<false>, pg8::SubOrder, true, true, true>(lds, g, S, E); }
                    else { pg8::EpiResNorm<true> E{X, X + (size_t)MCTX * D, X, modl + 5 * 1024, nullptr, a.in[z + I_FING], nullptr, 0, 0, xbuf, ncnt + 96 * 64, EPS};
                        pg8::gemm_phase<pg8::EpiResNorm<true>, pg8::SubOrder, true, true, true>(lds, g, S, E); } }
            } else { pg8::Gemm g{BIG, W16 + W_2, M, D, DFF}; pg8::StaticOrder S; S.init(M, D, G, bx); pg8::EpiRes E{X, X + (size_t)MCTX * D, X, modl + 5 * 1024};
                pg8::gemm_phase<pg8::EpiRes, pg8::StaticOrder, true, true>(lds, g, S, E); }
        } else {
            if (G == 256) { pg8::Gemm g{BIG, W16 + W_2, M, D, DFF}; pg8::SubOrder S; S.init2(MLAT, D, 256, bx, 32, 0);
                if constexpr (l + 1 < NLAYER) { pg8::EpiResNorm<false> E{X, X + (size_t)MCTX * D, X, modl + 5 * 1024, RB, a.in[z + I_N1G] + (l + 1) * D, MOD + (size_t)(l + 1) * 5 * 6144, 0, 1, xbuf, ncnt + 96 * 64, EPS};
                    pg8::gemm_phase<pg8::EpiResNorm<false>, pg8::SubOrder, true, true, true>(lds, g, S, E); }
                else { pg8::EpiResNorm<true> E{X, X + (size_t)MCTX * D, X, modl + 5 * 1024, nullptr, a.in[z + I_FING], nullptr, 0, 0, xbuf, ncnt + 96 * 64, EPS};
                    pg8::gemm_phase<pg8::EpiResNorm<true>, pg8::SubOrder, true, true, true>(lds, g, S, E); } }
        }
    }
}
template <int ph> __device__ __forceinline__ void run_phases(const Args& a, LAS unsigned char* lds, cg::grid_group& grid, const XcdBarrier& bar) {
    if constexpr (ph < NPHASES) {
        constexpr bool empty_phase = (ph == 1 + 3);
        constexpr bool fused_norm_phase = (ph == NPHASES - 1) || (ph >= 1 && ph < NPHASES - 1 && (ph - 1) % PH_PER_LAYER == 10);
        const bool g256 = (gridDim.x == 256);
        if (!empty_phase && !(fused_norm_phase && g256) && a.ph_lo <= ph && ph < a.ph_hi) { run_phase<ph>(a, lds); if (ph + 1 < a.ph_hi && !(g256 && ph + 1 == NPHASES - 1)) { if (a.ph_lo > a.ph_hi) grid.sync(); else xcd_barrier(bar); } }
        run_phases<ph + 1>(a, lds, grid, bar);
    }
}
__global__ void __launch_bounds__(NTHR, 2) fwd_kernel(Args a) {
    extern __shared__ __attribute__((aligned(16))) unsigned char lds_raw[];
    LAS unsigned char* lds = (LAS unsigned char*)lds_raw;
    cg::grid_group grid = cg::this_grid();
    volatile LAS unsigned* bst = (volatile LAS unsigned*)(lds + LDSCTL_OFF);
    if (threadIdx.x < 2) bst[threadIdx.x] = 0u;
    __syncthreads();
    const XcdBarrier bar = xcd_barrier_post((unsigned*)(a.ws + WS_CTL) + CW_BAR, bst);
    run_phases<0>(a, lds, grid, bar);
}

extern "C" void kernel_launch(void* const* d_in, const int* in_sizes, int n_in, void* d_out, int out_size, void* d_ws, size_t ws_size, hipStream_t stream) {
    static int grid = 0;
    if (grid == 0) {
        if (n_in != N_IN || ws_size < WS_END) { fprintf(stderr, "kernel_launch: n_in %d (want %d), ws %zu (want >= %zu): nothing launched\n", n_in, (int)N_IN, ws_size, (size_t)WS_END); grid = -1; return; }
        int dev = 0, cus = 0, per_cu = 0;
        if (hipGetDevice(&dev) != hipSuccess || hipDeviceGetAttribute(&cus, hipDeviceAttributeMultiprocessorCount, dev) != hipSuccess) { grid = -1; return; }
        if (hipFuncSetAttribute((const void*)fwd_kernel, hipFuncAttributeMaxDynamicSharedMemorySize, LDS_BYTES) != hipSuccess) { fprintf(stderr, "kernel_launch: hipFuncSetAttribute failed\n"); grid = -1; return; }
        if (hipOccupancyMaxActiveBlocksPerMultiprocessor(&per_cu, (const void*)fwd_kernel, NTHR, LDS_BYTES) != hipSuccess || per_cu < 1) { fprintf(stderr, "kernel_launch: occupancy query says %d\n", per_cu); (void)hipGetLastError(); grid = -1; return; }
        grid = cus;
    }
    if (grid < 0) return;
    if (hipMemsetAsync((char*)d_ws + WS_CTL, 0, CTL_ZERO_BYTES, stream) != hipSuccess) { fprintf(stderr, "kernel_launch: memset failed\n"); return; }
    Args a{};
    for (int i = 0; i < N_IN; ++i) a.in[i] = (const float*)d_in[i];
    a.out = (float*)d_out; a.ws = (unsigned char*)d_ws;
#if MK_PER_PHASE
    for (int ph = 0; ph < NPHASES; ++ph) { a.ph_lo = ph; a.ph_hi = ph + 1; hipLaunchKernelGGL(fwd_kernel, dim3(grid), dim3(NTHR), LDS_BYTES, stream, a); }
#else
    a.ph_lo = 0; a.ph_hi = NPHASES;
    void* args[] = {&a};
    hipError_t e = hipLaunchCooperativeKernel((const void*)fwd_kernel, dim3(grid), dim3(NTHR), args, LDS_BYTES, stream);
    if (e != hipSuccess) fprintf(stderr, "kernel_launch: cooperative launch failed: %s (grid %d)\n", hipGetErrorString(e), grid);
#endif
}
```

```cpp
#include <hip/hip_runtime.h>
#include <hip/hip_cooperative_groups.h>
#include <cstdio>
#include <cstdint>
namespace cg = cooperative_groups;

#ifndef MK_PER_PHASE
#define MK_PER_PHASE 0
#endif

namespace pg8 {
#define PG8_LAS __attribute__((address_space(3)))
typedef _Float16 f16_t;
typedef _Float16 f16x8 __attribute__((ext_vector_type(8)));
typedef float f32x4 __attribute__((ext_vector_type(4)));
typedef unsigned u32x4 __attribute__((ext_vector_type(4)));
constexpr int BM = 256, BK = 64, HALF = 128, HTB = HALF * BK * 2  , STAGE_BYTES = 8 * HTB, NXCD = 8, WGM = 8;

__host__ __device__ __forceinline__ int lds_byte(int r, int c) { const int st = (r >> 4) * 2 + (c >> 5), rr = r & 15, cc = c & 31, ob = rr * 64 + cc * 2; return st * 1024 + (ob ^ (((ob >> 9) & 1) << 5)); }
__host__ __device__ __forceinline__ void stage_rc(int b, int& R, int& C) { const int st = b / 1024, sb = b % 1024, swz = sb ^ (((sb >> 9) & 1) << 5); R = (st >> 1) * 16 + swz / 64; C = (st & 1) * 32 + (swz % 64) / 2; }
__host__ __device__ __forceinline__ int perm32(int rho) { const int n = rho >> 4, i = rho & 15; return 8 * (i >> 2) + 4 * n + (i & 3); }

struct Unit { int pm, pn, tag; };
struct Gemm { const f16_t* A; const f16_t* Bt; int M, N, K; };

struct StaticOrder {
    int nM, nN, nwg, G, c;
    __host__ __device__ void init(int M, int N, int G_, int c_) { nM = M / BM; nN = N / BM; nwg = nM * nN; G = G_; c = c_; }
    __host__ __device__ bool next(int i, Unit& u) const { const long L = (long)i * G + c; if (L >= nwg) return false; decode(L, u); return true; }
    __host__ __device__ void decode(long L, Unit& u) const {
        int wgid = (int)L; { const int q = nwg / NXCD, r = nwg % NXCD, xcd = wgid % NXCD, off = wgid / NXCD; wgid = (xcd < r ? xcd * (q + 1) : r * (q + 1) + (xcd - r) * q) + off; }
        const int nig = WGM * nN, gid = wgid / nig, fm = gid * WGM, gsz = (nM - fm) < WGM ? (nM - fm) : WGM;
        u.pm = fm + ((wgid % nig) % gsz); u.pn = (wgid % nig) / gsz; u.tag = 0;
    }
    __device__ __forceinline__ void a_ready(const Unit&) const {}
    __device__ __forceinline__ void done(const Unit&) const {}
};

struct SubOrder : StaticOrder {
    int pm0, kind;
    __device__ void init2(int Mv, int N, int Gv, int c_, int pm0_, int kind_) { init(Mv, N, Gv, c_); pm0 = pm0_; kind = kind_; }
    __device__ bool next(int i, Unit& u) const {
        long L;
        if (kind == 0) L = (long)i * G + c;
        else if (kind == 1) { if (i >= 6) return false; L = i < 2 ? i * 256 + c : (2 + ((i - 2) >> 1)) * 256 + c + 128 * ((i - 2) & 1); }
        else { if (i >= 2) return false; L = i * 256 + c; }
        if (L >= nwg) return false;
        decode(L, u); u.pm += pm0; return true;
    }
};

struct SeamOrder {
    int mode, x, j, nj; unsigned* cnt;
    __device__ void init(int mode_, int c, unsigned* cnt_) { mode = mode_; x = c & 7; j = c >> 3; nj = mode_ == 0 ? 32 : 16; cnt = cnt_; }
    __device__ bool next(int i, Unit& u) const {
        const int s = i * nj + j;
        if (mode == 0) { if (s >= 28) return false; const int o = 2 * x + (s & 1), ii = o & 3; u.pm = 32 + 16 * (o >> 2) + (ii < 2 ? ii : 12 + ii); u.pn = s >> 1; u.tag = 0; return true; }
        if (s >= 140) return false;
        if (s < 28) { const int o = 2 * x + (s & 1), ii = o & 3; u.pm = 32 + 16 * (o >> 2) + (ii < 2 ? 2 + ii : 10 + ii); u.pn = s >> 1; u.tag = (s + nj >= 28) ? 1 : 0; }
        else if (s < 84) {
            const int hb = s >= 56, s1 = s - (hb ? 56 : 28), k = s1 & 1; const int j2 = ((x & 1) != hb) ? 2 + k : k;
            u.pm = 32 + 16 * (x >> 1) + 4 + 4 * (x & 1) + j2; u.pn = s1 >> 1; u.tag = hb ? ((s + nj >= 84) ? 3 : 0) : ((s + nj >= 56) ? 2 : 0); }
        else { const int s2 = s - 84; u.pm = 4 * x + (s2 & 3); u.pn = s2 >> 2; u.tag = 0; }
        return true;
    }
    __device__ __forceinline__ void a_ready(const Unit&) const {}
    __device__ __forceinline__ void done(const Unit& u) const {
        if (u.tag) { asm volatile("s_waitcnt vmcnt(0)" ::: "memory"); __builtin_amdgcn_s_barrier();
            if (threadIdx.x == 0) { __builtin_amdgcn_fence(__ATOMIC_RELEASE, "agent"); asm volatile("s_waitcnt vmcnt(0)" ::: "memory"); (void)__hip_atomic_fetch_add(cnt + 64 * (u.tag - 1), 1u, __ATOMIC_RELAXED, __HIP_MEMORY_SCOPE_AGENT); } }
    }
};

typedef _Float16 f16x2 __attribute__((ext_vector_type(2)));
typedef float f32x2 __attribute__((ext_vector_type(2)));
__device__ __forceinline__ unsigned pk_f16(float lo, float hi) { f32x2 v = {lo, hi}; f16x2 h = __builtin_convertvector(v, f16x2); return __builtin_bit_cast(unsigned, h); }
__device__ __forceinline__ float f16lo(unsigned w) { f16x2 h = __builtin_bit_cast(f16x2, w); return (float)h.x; }
__device__ __forceinline__ float f16hi(unsigned w) { f16x2 h = __builtin_bit_cast(f16x2, w); return (float)h.y; }
__device__ __forceinline__ float fast_sigmoid(float x) { return __builtin_amdgcn_rcpf(1.0f + __expf(-x)); }
__device__ __forceinline__ float gelu_tanh(float x) { const float y = 1.5957691216057308f * (x + 0.044715f * x * x * x); return x * __builtin_amdgcn_rcpf(1.0f + __expf(-y)); }
template <int ACT> __device__ __forceinline__ float act_fn(float x) {
    if (ACT == 1) return gelu_tanh(x);
    if (ACT == 2) return fast_sigmoid(x);
    if (ACT == 3) { const float r = x > 0.f ? x : 0.f; return r * r; }
    return x;
}
template <int ACT> struct EpiH16 {
    static constexpr bool PERM = true, AFTER_DRAIN = false;
    f16_t* O; int ldc; int split_cols; size_t split_stride;
    __device__ __forceinline__ void operator()(const f32x4 (&acc)[2][2][4][2], const Unit& u, int wr, int wc, int fr, int fq) const {
        const int row0 = u.pm * BM + wr * 64 + fr; int colt = u.pn * BM; f16_t* base = O;
        if (split_cols) { const int t = colt / split_cols; base += (size_t)t * split_stride; colt -= t * split_cols; }
        const int col0 = colt + wc * 32 + 8 * fq;
#pragma unroll
        for (int ai = 0; ai < 2; ++ai)
#pragma unroll
            for (int m = 0; m < 4; ++m) { f16_t* rowp = base + (size_t)(row0 + ai * HALF + m * 16) * ldc + col0;
#pragma unroll
                for (int bj = 0; bj < 2; ++bj) { const f32x4 v0 = acc[ai][bj][m][0], v1 = acc[ai][bj][m][1];
                    u32x4 w; w.x = pk_f16(act_fn<ACT>(v0[0]), act_fn<ACT>(v0[1])); w.y = pk_f16(act_fn<ACT>(v0[2]), act_fn<ACT>(v0[3]));
                    w.z = pk_f16(act_fn<ACT>(v1[0]), act_fn<ACT>(v1[1])); w.w = pk_f16(act_fn<ACT>(v1[2]), act_fn<ACT>(v1[3]));
                    *(u32x4*)(rowp + bj * HALF) = w; } }
    }
};
template <int ACT> struct EpiH16B {
    static constexpr bool PERM = true, AFTER_DRAIN = false;
    f16_t* O; int ldc;
    __device__ __forceinline__ void operator()(const f32x4 (&acc)[2][2][4][2], const Unit& u, int wr, int wc, int fr, int fq) const {
        f16_t* base = O + (size_t)u.pm * BM * ldc + (size_t)(wr * 64 + fr) * BK;
#pragma unroll
        for (int bj = 0; bj < 2; ++bj) { const int c = u.pn * BM + bj * HALF + wc * 32 + 8 * fq; f16_t* cp = base + (size_t)(c >> 6) * (BM * BK) + (c & 63);
#pragma unroll
            for (int ai = 0; ai < 2; ++ai)
#pragma unroll
                for (int m = 0; m < 4; ++m) { const f32x4 v0 = acc[ai][bj][m][0], v1 = acc[ai][bj][m][1];
                    u32x4 w; w.x = pk_f16(act_fn<ACT>(v0[0]), act_fn<ACT>(v0[1])); w.y = pk_f16(act_fn<ACT>(v0[2]), act_fn<ACT>(v0[3]));
                    w.z = pk_f16(act_fn<ACT>(v1[0]), act_fn<ACT>(v1[1])); w.w = pk_f16(act_fn<ACT>(v1[2]), act_fn<ACT>(v1[3]));
                    *(u32x4*)(cp + (ai * HALF + m * 16) * BK) = w; } }
    }
};
template <bool ADD> struct EpiMix {
    static constexpr bool PERM = true, AFTER_DRAIN = false;
    f16_t* MIX; const f16_t* G; int gcol;
    __device__ __forceinline__ void operator()(const f32x4 (&acc)[2][2][4][2], const Unit& u, int wr, int wc, int fr, int fq) const {
        const int row0 = u.pm * BM + wr * 64 + fr; const int col0 = u.pn * BM + wc * 32 + 8 * fq;
#pragma unroll
        for (int ai = 0; ai < 2; ++ai)
#pragma unroll
            for (int m = 0; m < 4; ++m) { const size_t row = (size_t)(row0 + ai * HALF + m * 16);
#pragma unroll
                for (int bj = 0; bj < 2; ++bj) { const f32x4 v0 = acc[ai][bj][m][0], v1 = acc[ai][bj][m][1];
                    const u32x4 g = *(const u32x4*)(G + row * 2048 + gcol + col0 + bj * HALF);
                    float o[8] = {v0[0] * f16lo(g.x), v0[1] * f16hi(g.x), v0[2] * f16lo(g.y), v0[3] * f16hi(g.y), v1[0] * f16lo(g.z), v1[1] * f16hi(g.z), v1[2] * f16lo(g.w), v1[3] * f16hi(g.w)};
                    f16_t* p = MIX + row * 1024 + col0 + bj * HALF;
                    if (ADD) { const u32x4 q = *(const u32x4*)p; o[0] += f16lo(q.x); o[1] += f16hi(q.x); o[2] += f16lo(q.y); o[3] += f16hi(q.y); o[4] += f16lo(q.z); o[5] += f16hi(q.z); o[6] += f16lo(q.w); o[7] += f16hi(q.w); }
                    u32x4 w; w.x = pk_f16(o[0], o[1]); w.y = pk_f16(o[2], o[3]); w.z = pk_f16(o[4], o[5]); w.w = pk_f16(o[6], o[7]);
                    *(u32x4*)p = w; } }
    }
};
struct EpiRes {
    static constexpr bool PERM = false, AFTER_DRAIN = false;
    const float* base_ctx; const float* base_lat; float* X; const float* gate;
    __device__ __forceinline__ void operator()(const f32x4 (&acc)[2][2][4][2], const Unit& u, int wr, int wc, int fr, int fq) const {
        const int row0 = u.pm * BM + wr * 64 + fr, col0 = u.pn * BM + wc * 32 + 4 * fq;
        const int s = u.pm < 32 ? 0 : 1 + ((u.pm - 32) >> 4);
        const float* gp = gate + s * 6144 + col0;
        f32x4 gv[2][2];
#pragma unroll
        for (int bj = 0; bj < 2; ++bj)
#pragma unroll
            for (int n = 0; n < 2; ++n) gv[bj][n] = *(const f32x4*)(gp + bj * HALF + n * 16);
#pragma unroll
        for (int ai = 0; ai < 2; ++ai)
#pragma unroll
            for (int m = 0; m < 4; ++m) { const int row = row0 + ai * HALF + m * 16;
                const float* bp = (row < 8192 ? base_ctx + (size_t)row * 1024 : base_lat + (size_t)(row - 8192) * 1024) + col0;
                float* xp = X + (size_t)row * 1024 + col0;
#pragma unroll
                for (int bj = 0; bj < 2; ++bj)
#pragma unroll
                    for (int n = 0; n < 2; ++n) { const f32x4 b = *(const f32x4*)(bp + bj * HALF + n * 16); *(f32x4*)(xp + bj * HALF + n * 16) = b + gv[bj][n] * acc[ai][bj][m][n]; } }
    }
};
template <bool FINAL> struct EpiResNorm {
    static constexpr bool PERM = false, AFTER_DRAIN = true;
    const float* base_ctx; const float* base_lat; float* X; const float* gate;
    f16_t* H; const float* gain; const float* modn; int sh_idx, sc_idx;
    float* xbuf; unsigned* cnt; float eps;
    __device__ __forceinline__ void fused(f32x4 (&acc)[2][2][4][2], const Unit& u, int wr, int wc, int fr, int fq, PG8_LAS unsigned char* lds, int wid, int lane) const {
        PG8_LAS float* P = (PG8_LAS float*)lds; PG8_LAS float* S = (PG8_LAS float*)(lds + 8192);
        const int row0 = u.pm * BM + wr * 64 + fr, col0 = u.pn * BM + wc * 32 + 4 * fq;
        const int s = u.pm < 32 ? 0 : 1 + ((u.pm - 32) >> 4);
        {
            const float* gp = gate + s * 6144 + col0;
            f32x4 gv[2][2];
#pragma unroll
            for (int bj = 0; bj < 2; ++bj)
#pragma unroll
                for (int n = 0; n < 2; ++n) gv[bj][n] = *(const f32x4*)(gp + bj * HALF + n * 16);
#pragma unroll
            for (int ai = 0; ai < 2; ++ai)
#pragma unroll
                for (int m = 0; m < 4; ++m) { const int row = row0 + ai * HALF + m * 16;
                    const float* bp = (row < 8192 ? base_ctx + (size_t)row * 1024 : base_lat + (size_t)(row - 8192) * 1024) + col0;
                    float* xp = X + (size_t)row * 1024 + col0; float ss = 0.f;
#pragma unroll
                    for (int bj = 0; bj < 2; ++bj)
#pragma unroll
                        for (int n = 0; n < 2; ++n) { const f32x4 b = *(const f32x4*)(bp + bj * HALF + n * 16); const f32x4 x = b + gv[bj][n] * acc[ai][bj][m][n]; acc[ai][bj][m][n] = x;
                            if (!FINAL) *(f32x4*)(xp + bj * HALF + n * 16) = x;
                            ss += (x[0] * x[0] + x[1] * x[1]) + (x[2] * x[2] + x[3] * x[3]); }
                    ss += __shfl_xor(ss, 16); ss += __shfl_xor(ss, 32);
                    if (fq == 0) P[(ai * HALF + wr * 64 + m * 16 + fr) * 4 + wc] = ss;
                    asm volatile("" ::: "memory"); }
        }
        asm volatile("s_waitcnt lgkmcnt(0)" ::: "memory"); __builtin_amdgcn_s_barrier(); asm volatile("" ::: "memory");
        const int row = wid * 32 + (lane & 31);
        if (lane < 32) { const f32x4 p = *(const PG8_LAS f32x4*)(P + row * 4);
            __hip_atomic_store(xbuf + ((size_t)(u.pm * BM + row) * 4 + u.pn), (p[0] + p[1]) + (p[2] + p[3]), __ATOMIC_RELAXED, __HIP_MEMORY_SCOPE_AGENT); }
        asm volatile("s_waitcnt vmcnt(0)" ::: "memory");
        if (lane == 0) (void)__hip_atomic_fetch_add(cnt + 64 * u.pm, 1u, __ATOMIC_RELAXED, __HIP_MEMORY_SCOPE_AGENT);
        if (wid == 0) { unsigned spins = 0;
            while ((unsigned)__builtin_amdgcn_readfirstlane(__hip_atomic_load(cnt + 64 * u.pm, __ATOMIC_RELAXED, __HIP_MEMORY_SCOPE_AGENT)) < 32u) { __builtin_amdgcn_s_sleep(2); if (++spins > (1u << 22)) break; }
            __builtin_amdgcn_fence(__ATOMIC_ACQUIRE, "agent"); }
        asm volatile("s_waitcnt vmcnt(0) lgkmcnt(0)" ::: "memory"); __builtin_amdgcn_s_barrier(); asm volatile("" ::: "memory");
        if (lane < 32) { const float* sl = xbuf + (size_t)(u.pm * BM + row) * 4; float t = 0.f;
#pragma unroll
            for (int k = 0; k < 4; ++k) t += __hip_atomic_load(sl + k, __ATOMIC_RELAXED, __HIP_MEMORY_SCOPE_AGENT);
            S[row] = __builtin_amdgcn_rsqf(t * (1.0f / 1024.0f) + eps); }
        asm volatile("s_waitcnt lgkmcnt(0)" ::: "memory"); __builtin_amdgcn_s_barrier(); asm volatile("" ::: "memory");
#pragma unroll
        for (int bj = 0; bj < 2; ++bj)
#pragma unroll
            for (int n = 0; n < 2; ++n) { const int c = col0 + bj * HALF + n * 16;
                f32x4 gm = *(const f32x4*)(gain + c), sh = {0.f, 0.f, 0.f, 0.f};
                if (!FINAL) { gm = gm * (*(const f32x4*)(modn + (size_t)s * 6144 + sc_idx * 1024 + c) + 1.0f); sh = *(const f32x4*)(modn + (size_t)s * 6144 + sh_idx * 1024 + c); }
#pragma unroll
                for (int ai = 0; ai < 2; ++ai)
#pragma unroll
                    for (int m = 0; m < 4; ++m) { const int r = ai * HALF + wr * 64 + m * 16 + fr; const float rs = S[r]; const size_t off = (size_t)(u.pm * BM + r) * 1024 + c;
                        const f32x4 y = acc[ai][bj][m][n] * rs * gm + sh;
                        if (FINAL) *(f32x4*)(X + off) = y;
                        else { typedef unsigned u32x2p __attribute__((ext_vector_type(2))); u32x2p w; w.x = pk_f16(y[0], y[1]); w.y = pk_f16(y[2], y[3]); *(u32x2p*)(H + off) = w; } }
            }
    }
};

template <class Epi, class Sched, bool ALIGN_EPI = false, bool SP2 = false, bool ABLK = false>
__device__ __forceinline__ void gemm_phase(PG8_LAS unsigned char* lds, const Gemm g, const Sched& S, const Epi& E) {
    const int tid = threadIdx.x, wid = __builtin_amdgcn_readfirstlane(tid >> 6), lane = tid & 63, wr = wid >> 2, wc = wid & 3, fr = lane & 15, fq = lane >> 4;
    const int K = g.K, nt = K / BK;
    unsigned voffA[2], voffB[2];
#pragma unroll
    for (int i = 0; i < 2; ++i) { int R, C; stage_rc(tid * 16 + i * 8192, R, C); const int Rb = Epi::PERM ? ((R & ~31) + perm32(R & 31)) : R;
        voffA[i] = (unsigned)(R * (ABLK ? BK : K) + C) * 2u; voffB[i] = (unsigned)(Rb * K + C) * 2u; }
    const size_t kstep = (size_t)(BK * 2);
    const size_t hstep = (size_t)HALF * K * 2;
    const size_t tstep = 2 * hstep;
    const size_t kstepA = ABLK ? (size_t)BM * BK * 2 : kstep, hstepA = ABLK ? (size_t)HALF * BK * 2 : hstep;
    const unsigned ldsw = (unsigned)wid * 1024u;
    const int aoff = lds_byte(wr * 64 + fr, fq * 8), boff = lds_byte(wc * 32 + fr, fq * 8);
#define PG8_SA(b, h) (((b) * 2 + (h)) * HTB)
#define PG8_SB(b, h) ((4 + (b) * 2 + (h)) * HTB)
#define PG8_STAGE(bufoff, gbase, voff) do { _Pragma("unroll") for (int _i = 0; _i < 2; ++_i) \
        __builtin_amdgcn_global_load_lds((const unsigned*)((const char*)(gbase) + (voff)[_i]), (PG8_LAS unsigned*)(lds + (bufoff) + ldsw + _i * 8192), 16, 0, 0); } while (0)
#define PG8_LDA(dst, b, h) do { _Pragma("unroll") for (int m = 0; m < 4; ++m) _Pragma("unroll") for (int k = 0; k < 2; ++k) dst[m][k] = *(const PG8_LAS f16x8*)(lds + PG8_SA(b, h) + aoff + m * 2048 + k * 1024); } while (0)
#define PG8_LDB(dst, b, h) do { _Pragma("unroll") for (int n = 0; n < 2; ++n) _Pragma("unroll") for (int k = 0; k < 2; ++k) dst[n][k] = *(const PG8_LAS f16x8*)(lds + PG8_SB(b, h) + boff + n * 2048 + k * 1024); } while (0)
#define PG8_MMA(ai, bj, At, Bt) do { __builtin_amdgcn_s_setprio(1); _Pragma("unroll") for (int m = 0; m < 4; ++m) _Pragma("unroll") for (int n = 0; n < 2; ++n) _Pragma("unroll") for (int k = 0; k < 2; ++k) \
        acc[ai][bj][m][n] = __builtin_amdgcn_mfma_f32_16x16x32_f16(Bt[n][k], At[m][k], acc[ai][bj][m][n], 0, 0, 0); __builtin_amdgcn_s_setprio(0); } while (0)
#define PG8_WAIT_V(n) asm volatile("s_waitcnt vmcnt(" #n ")" ::: "memory")
#define PG8_WAIT_L(n) asm volatile("s_waitcnt lgkmcnt(" #n ")" ::: "memory")
#define PG8_BAR __builtin_amdgcn_s_barrier()
#define PG8_SCHED __builtin_amdgcn_sched_barrier(0)
    Unit cur, nxt; int ui = 0;
    if (!S.next(0, cur)) return;
    f32x4 acc[2][2][4][2];
#pragma unroll
    for (int a = 0; a < 2; ++a)
#pragma unroll
        for (int b = 0; b < 2; ++b)
#pragma unroll
            for (int m = 0; m < 4; ++m)
#pragma unroll
                for (int n = 0; n < 2; ++n) acc[a][b][m][n] = (f32x4){0.f, 0.f, 0.f, 0.f};
    f16x8 At[4][2], B0[2][2], B1[2][2];
    const char* cA = (const char*)g.A + (size_t)cur.pm * tstep; const char* cB = (const char*)g.Bt + (size_t)cur.pn * tstep;
    S.a_ready(cur);
    if constexpr (SP2) {
        PG8_STAGE(PG8_SB(0, 0), cB, voffB); PG8_STAGE(PG8_SB(0, 1), cB + hstep, voffB); PG8_STAGE(PG8_SA(0, 0), cA, voffA); PG8_STAGE(PG8_SA(0, 1), cA + hstepA, voffA);
        if (wr == 1) PG8_BAR;
        PG8_WAIT_V(2); PG8_BAR;
        PG8_STAGE(PG8_SB(1, 0), cB + kstep, voffB); PG8_STAGE(PG8_SA(1, 0), cA + kstepA, voffA); PG8_STAGE(PG8_SB(1, 1), cB + hstep + kstep, voffB);
        PG8_WAIT_V(6); PG8_BAR;
    } else {
        PG8_STAGE(PG8_SB(0, 0), cB, voffB); PG8_STAGE(PG8_SA(0, 0), cA, voffA); PG8_STAGE(PG8_SB(0, 1), cB + hstep, voffB); PG8_STAGE(PG8_SA(0, 1), cA + hstepA, voffA);
        if (wr == 1) PG8_BAR;
        PG8_WAIT_V(4); PG8_BAR;
        PG8_STAGE(PG8_SB(1, 0), cB + kstep, voffB); PG8_STAGE(PG8_SA(1, 0), cA + kstepA, voffA); PG8_STAGE(PG8_SB(1, 1), cB + hstep + kstep, voffB);
        PG8_WAIT_V(6); PG8_BAR;
    }
    for (;;) {
        const bool has_next = S.next(ui + 1, nxt);
        const char* nA = has_next ? (const char*)g.A + (size_t)nxt.pm * tstep : cA; const char* nB = has_next ? (const char*)g.Bt + (size_t)nxt.pn * tstep : cB;
        for (int t = 0; t < nt; t += 2) {
            const bool last = (t == nt - 2);
            const char* a1 = cA + (size_t)(t + 1) * kstepA;
            const char* a2 = last ? nA : cA + (size_t)(t + 2) * kstepA; const char* b2 = last ? nB : cB + (size_t)(t + 2) * kstep;
            const char* a3 = a2 + kstepA; const char* b3 = b2 + kstep;
            if (last && has_next) S.a_ready(nxt);
            if constexpr (SP2) {
            PG8_LDB(B0, 0, 0); PG8_LDB(B1, 0, 1); PG8_SCHED; PG8_LDA(At, 0, 0); PG8_STAGE(PG8_SA(1, 1), a1 + hstepA, voffA);
            PG8_WAIT_V(8); PG8_WAIT_L(0); PG8_BAR; PG8_MMA(0, 0, At, B0); PG8_MMA(0, 1, At, B1); PG8_BAR; PG8_SCHED;
            PG8_LDA(At, 0, 1); PG8_STAGE(PG8_SB(0, 0), b2, voffB); PG8_STAGE(PG8_SB(0, 1), b2 + hstep, voffB); PG8_STAGE(PG8_SA(0, 0), a2, voffA);
            PG8_WAIT_V(8); PG8_WAIT_L(0); PG8_BAR; PG8_MMA(1, 0, At, B0); PG8_MMA(1, 1, At, B1); PG8_BAR; PG8_SCHED;
            PG8_LDB(B0, 1, 0); PG8_LDB(B1, 1, 1); PG8_SCHED; PG8_LDA(At, 1, 0); PG8_STAGE(PG8_SA(0, 1), a2 + hstepA, voffA);
            PG8_WAIT_V(8); PG8_WAIT_L(0); PG8_BAR; PG8_MMA(0, 0, At, B0); PG8_MMA(0, 1, At, B1); PG8_BAR; PG8_SCHED;
            PG8_LDA(At, 1, 1); PG8_STAGE(PG8_SB(1, 0), b3, voffB); PG8_STAGE(PG8_SB(1, 1), b3 + hstep, voffB); PG8_STAGE(PG8_SA(1, 0), a3, voffA);
            PG8_WAIT_V(8); PG8_WAIT_L(0); PG8_BAR; PG8_MMA(1, 0, At, B0); PG8_MMA(1, 1, At, B1); PG8_BAR; PG8_SCHED;
            } else {
            PG8_LDB(B0, 0, 0); PG8_SCHED; PG8_LDA(At, 0, 0); PG8_STAGE(PG8_SA(1, 1), a1 + hstepA, voffA);
            PG8_WAIT_L(8); PG8_BAR; PG8_WAIT_L(0); PG8_MMA(0, 0, At, B0); PG8_BAR; PG8_SCHED;
            PG8_LDB(B1, 0, 1); PG8_STAGE(PG8_SB(0, 0), b2, voffB);
            PG8_BAR; PG8_WAIT_L(0); PG8_MMA(0, 1, At, B1); PG8_BAR;
            PG8_LDA(At, 0, 1); PG8_STAGE(PG8_SA(0, 0), a2, voffA);
            PG8_BAR; PG8_WAIT_L(0); PG8_MMA(1, 0, At, B0); PG8_BAR; PG8_SCHED;
            PG8_STAGE(PG8_SB(0, 1), b2 + hstep, voffB);
            PG8_WAIT_V(6); PG8_BAR; PG8_MMA(1, 1, At, B1); PG8_BAR;
            PG8_LDB(B0, 1, 0); PG8_SCHED; PG8_LDA(At, 1, 0); PG8_STAGE(PG8_SA(0, 1), a2 + hstepA, voffA);
            PG8_WAIT_L(8); PG8_BAR; PG8_WAIT_L(0); PG8_MMA(0, 0, At, B0); PG8_BAR; PG8_SCHED;
            PG8_LDB(B1, 1, 1); PG8_STAGE(PG8_SB(1, 0), b3, voffB);
            PG8_BAR; PG8_WAIT_L(0); PG8_MMA(0, 1, At, B1); PG8_BAR;
            PG8_LDA(At, 1, 1); PG8_STAGE(PG8_SA(1, 0), a3, voffA);
            PG8_BAR; PG8_WAIT_L(0); PG8_MMA(1, 0, At, B0); PG8_BAR; PG8_SCHED;
            PG8_STAGE(PG8_SB(1, 1), b3 + hstep, voffB);
            PG8_WAIT_V(6); PG8_BAR; PG8_MMA(1, 1, At, B1); PG8_BAR;
            }
        }
        if constexpr (ALIGN_EPI) { if (wr == 0) PG8_BAR; }
        if constexpr (!Epi::AFTER_DRAIN) { E(acc, cur, wr, wc, fr, fq); S.done(cur); }
        if (!has_next) break;
#pragma unroll
        for (int a = 0; a < 2; ++a)
#pragma unroll
            for (int b = 0; b < 2; ++b)
#pragma unroll
                for (int m = 0; m < 4; ++m)
#pragma unroll
                    for (int n = 0; n < 2; ++n) acc[a][b][m][n] = (f32x4){0.f, 0.f, 0.f, 0.f};
        cur = nxt; cA = nA; cB = nB; ++ui;
        if constexpr (ALIGN_EPI) { if (wr == 1) PG8_BAR; }
    }
    PG8_WAIT_V(0);
    if constexpr (!ALIGN_EPI) { if (wr == 0) PG8_BAR; }
    PG8_BAR;
    if constexpr (Epi::AFTER_DRAIN) { E.fused(acc, cur, wr, wc, fr, fq, lds, wid, lane); S.done(cur); }
#undef PG8_SA
#undef PG8_SB
#undef PG8_STAGE
#undef PG8_LDA
#undef PG8_LDB
#undef PG8_MMA
#undef PG8_WAIT_V
#undef PG8_WAIT_L
#undef PG8_BAR
#undef PG8_SCHED
}
}

constexpr int NWAVES = 8, NTHR = 512;
constexpr int D = 1024, MCTX = 8192, MLAT = 16384, M = MCTX + MLAT;
constexpr int TCTX = 256, TLAT = 4096, BCTX = 32, BLAT = 4, NH = 16, HD = 64;
constexpr int DIN = 7552, CRW = 3456, ZRN = 3584, DFF = 4096;
constexpr int NLAYER = 2;
constexpr float EPS = 1e-6f, GN_EPS = 64e-5f, DECAY_SCALE = 0.6065306597126334f;
enum { I_XP = 0, I_XS, I_STATE, I_C, I_CCTX, I_WADA, I_BADA, I_N1G, I_N2G, I_WIN, I_MU, I_W0, I_WUP, I_A0, I_AUP, I_GUP, I_KK, I_KA, I_RK, I_LNXG, I_LNXB, I_WBA, I_LNVG, I_WS, I_BS, I_WBB, I_WOUT, I_W1, I_W2, I_FING, N_IN };

constexpr size_t MiB = 1u << 20;
constexpr size_t WS_CTL = 0, CTL_ZERO_BYTES = 1 * MiB;
constexpr size_t WS_MOD = 1 * MiB;
constexpr size_t WS_BON = 2 * MiB;
constexpr size_t WS_SMALL = 4 * MiB;
constexpr size_t SM_WUP = 0, SM_AUP = 524288, SM_GUP = 1048576, SM_WS = 1572864;
constexpr size_t WS_W16 = 8 * MiB;
constexpr size_t W_INR = 0, W_INUV = (size_t)3584 * 1024, W_ING = (size_t)5632 * 1024, W_A = (size_t)7680 * 1024, W_B = (size_t)8704 * 1024, W_OUT = (size_t)9728 * 1024,
                 W_1 = (size_t)10752 * 1024, W_2 = (size_t)14848 * 1024, W_END = (size_t)18944 * 1024;
constexpr size_t WS_B = 48 * MiB;
constexpr size_t WS_BIG = 96 * MiB;
constexpr size_t WS_END = 288 * MiB;
static_assert(WS_W16 + W_END * 2 <= WS_B && WS_BIG + (size_t)M * DFF * 2 <= WS_END && (size_t)M * ZRN * 2 <= 192 * MiB, "ws map");

constexpr int RING_BYTES = 131072;
constexpr int LDS_BYTES = 147456;

#define LAS __attribute__((address_space(3)))
typedef _Float16 f16;
typedef _Float16 f16x4 __attribute__((ext_vector_type(4)));
typedef _Float16 f16x8 __attribute__((ext_vector_type(8)));
typedef float f32x4 __attribute__((ext_vector_type(4)));
typedef unsigned u32x2 __attribute__((ext_vector_type(2)));
typedef unsigned u32x4 __attribute__((ext_vector_type(4)));
typedef short v4i16_t __attribute__((ext_vector_type(4)));
using pg8::pk_f16; using pg8::f16lo; using pg8::f16hi; using pg8::fast_sigmoid;

struct Args { const float* in[N_IN]; float* out; unsigned char* ws; int ph_lo, ph_hi; };
static_assert(sizeof(Args) == N_IN * 8 + 8 + 8 + 8, "Args has no padding");

__device__ __forceinline__ float wave_sum(float v) {
#pragma unroll
    for (int o = 1; o < 64; o <<= 1) v += __shfl_xor(v, o);
    return v;
}
#define LDS_WAIT() asm volatile("s_waitcnt lgkmcnt(0)" ::: "memory")

__host__ __device__ __forceinline__ int perm_o(int p) { return 4 * (p & 15) + (p >> 4); }
__host__ __device__ __forceinline__ int perm_inv(int c) { return ((c & 3) << 4) + (c >> 2); }
__device__ __forceinline__ void transpose_item(const float* W, int K, int N, f16* WT, int split, int split_add, int permn_below, bool permk, LAS float* scr, int item, int lane) {
    const int nblk = N / 32, kb = item / nblk, nb = item % nblk, k0 = 64 * kb, n0 = 32 * nb;
#pragma unroll 8
    for (int i = 0; i < 32; ++i) { const int kk = 2 * i + (lane >> 5); const int ks = permk ? perm_o(kk) : kk; scr[kk * 33 + (lane & 31)] = W[(size_t)(k0 + ks) * N + n0 + (lane & 31)]; }
    LDS_WAIT(); asm volatile("" ::: "memory");
    const int c = lane & 7;
#pragma unroll
    for (int j = 0; j < 4; ++j) { const int n = (lane >> 3) + 8 * j; const LAS float* s = scr + (8 * c) * 33 + n; const int ng = n0 + n;
        const int drow = ng < permn_below ? (ng & ~63) + perm_inv(ng & 63) : ng + (ng >= split ? split_add : 0);
        u32x4 o; o.x = pk_f16(s[0 * 33], s[1 * 33]); o.y = pk_f16(s[2 * 33], s[3 * 33]); o.z = pk_f16(s[4 * 33], s[5 * 33]); o.w = pk_f16(s[6 * 33], s[7 * 33]);
        *(u32x4*)(WT + (size_t)drow * K + k0 + 8 * c) = o; }
    LDS_WAIT(); asm volatile("" ::: "memory");
}
__device__ __forceinline__ void convert_layer_weights(const Args& a, int z, int l, LAS unsigned char* lds, int gw, int ngw, int wave, int lane, int gtid, int ngt) {
    LAS float* scr = (LAS float*)(lds + wave * 16384);
    f16* W16 = (f16*)(a.ws + WS_W16);
    constexpr int I_IN = 16 * (DIN / 32), I_SQ = 16 * 32, I_1 = 16 * (DFF / 32), I_2 = (DFF / 64) * 32;
    constexpr int NITEMS = I_IN + 3 * I_SQ + I_1 + I_2;
    for (int it = gw; it < NITEMS; it += ngw) {
        int r = it;
        if (r < I_IN) { transpose_item(a.in[z + I_WIN] + (size_t)l * D * DIN, D, DIN, W16 + W_INR, CRW, 128, CRW, false, scr, r, lane); continue; } r -= I_IN;
        if (r < I_SQ) { transpose_item(a.in[z + I_WBA] + (size_t)l * D * D, D, D, W16 + W_A, 1 << 30, 0, 0, true, scr, r, lane); continue; } r -= I_SQ;
        if (r < I_SQ) { transpose_item(a.in[z + I_WBB] + (size_t)l * D * D, D, D, W16 + W_B, 1 << 30, 0, 0, false, scr, r, lane); continue; } r -= I_SQ;
        if (r < I_SQ) { transpose_item(a.in[z + I_WOUT] + (size_t)l * D * D, D, D, W16 + W_OUT, 1 << 30, 0, 0, false, scr, r, lane); continue; } r -= I_SQ;
        if (r < I_1) { transpose_item(a.in[z + I_W1] + (size_t)l * D * DFF, D, DFF, W16 + W_1, 1 << 30, 0, 0, false, scr, r, lane); continue; } r -= I_1;
        transpose_item(a.in[z + I_W2] + (size_t)l * DFF * D, DFF, D, W16 + W_2, 1 << 30, 0, 0, false, scr, r, lane);
    }
    u32x4* pad = (u32x4*)(W16 + W_INR + (size_t)CRW * 1024);
    for (int i = gtid; i < 128 * 1024 / 8; i += ngt) pad[i] = (u32x4){0u, 0u, 0u, 0u};
}
__device__ __forceinline__ void p0_prologue(const Args& a, int z, LAS unsigned char* lds, int G, int bx, int tid, int wave, int lane) {
    const int gw = bx * NWAVES + wave, ngw = G * NWAVES, gtid = bx * NTHR + tid, ngt = G * NTHR;
    {
        LAS float* SC = (LAS float*)lds;
        LAS float* P = (LAS float*)(lds + 20480);
        float* MOD = (float*)(a.ws + WS_MOD);
        bool have_sc = false;
        for (int item = bx; item < NLAYER * 96; item += G) {
            if (!have_sc) {
                for (int i = tid; i < 5 * 1024; i += NTHR) { const float x = (i < 1024) ? a.in[z + I_CCTX][i] : a.in[z + I_C][i - 1024]; SC[i] = x * fast_sigmoid(x); }
                have_sc = true;
            }
            __syncthreads();
            const int l = item / 96, n0 = (item % 96) * 64;
            const float* wp = a.in[z + I_WADA] + ((size_t)l * 1024 + wave * 128) * 6144 + n0 + lane;
            float acc[5] = {0.f, 0.f, 0.f, 0.f, 0.f};
#pragma unroll 8
            for (int kk = 0; kk < 128; ++kk) { const float wv = wp[(size_t)kk * 6144]; const int k = wave * 128 + kk;
#pragma unroll
                for (int s = 0; s < 5; ++s) acc[s] += SC[s * 1024 + k] * wv; }
#pragma unroll
            for (int s = 0; s < 5; ++s) P[(wave * 5 + s) * 64 + lane] = acc[s];
            __syncthreads();
            if (tid < 320) { const int s = tid >> 6, ln = tid & 63; float v = a.in[z + I_BADA][l * 6144 + n0 + ln];
#pragma unroll
                for (int w = 0; w < 8; ++w) v += P[(w * 5 + s) * 64 + ln];
                MOD[((size_t)l * 5 + s) * 6144 + n0 + ln] = v; }
        }
        __syncthreads();
    }
    {
        LAS float* scr = (LAS float*)(lds + wave * 16384);
        unsigned char* sm = a.ws + WS_SMALL;
        for (int it = gw; it < 128 + 128 + 128; it += ngw) {
            if (it < 128) { const int ld = it >> 5; transpose_item(a.in[z + I_WUP] + (size_t)ld * 64 * 1024, 64, 1024, (f16*)(sm + SM_WUP) + (size_t)ld * 1024 * 64, 1 << 30, 0, 0, true, scr, it & 31, lane); }
            else if (it < 256) { const int ld = (it - 128) >> 5; transpose_item(a.in[z + I_AUP] + (size_t)ld * 64 * 1024, 64, 1024, (f16*)(sm + SM_AUP) + (size_t)ld * 1024 * 64, 1 << 30, 0, 0, true, scr, it & 31, lane); }
            else { const int l = (it - 256) >> 6; transpose_item(a.in[z + I_GUP] + (size_t)l * 128 * 1024, 128, 1024, (f16*)(sm + SM_GUP) + (size_t)l * 1024 * 128, 1 << 30, 0, 0, true, scr, it & 63, lane); }
        }
        f16* ws16 = (f16*)(sm + SM_WS); const float* wsrc = a.in[z + I_WS];
        for (int i = gtid; i < NLAYER * 8 * 128 * 128 / 4; i += ngt) { const f32x4 v = *(const f32x4*)(wsrc + (size_t)i * 4); u32x2 o; o.x = pk_f16(v[0], v[1]); o.y = pk_f16(v[2], v[3]); *(u32x2*)(ws16 + (size_t)i * 4) = o; }
    }
    convert_layer_weights(a, z, 0, lds, gw, ngw, wave, lane, gtid, ngt);
}

__device__ __forceinline__ const float* xrow_ptr(const float* base_ctx, const float* base_lat, int row) { return row < MCTX ? base_ctx + (size_t)row * D : base_lat + (size_t)(row - MCTX) * D; }
__device__ __forceinline__ int row_stream(int row) { return row < MCTX ? 0 : 1 + ((row - MCTX) >> 12); }
__device__ __forceinline__ void norm_phase(const float* base_ctx, const float* base_lat, const float* gain, const float* modl, int sh_idx, int sc_idx, f16* H, int gw, int ngw, int lane) {
    const int rpw = (M + ngw - 1) / ngw; const int r0 = gw * rpw, r1 = (r0 + rpw < M) ? r0 + rpw : M;
    int cur_s = -1; f32x4 gm[4], sh[4];
    f32x4 nv[4];
    if (r0 < r1) { const f32x4* xn = (const f32x4*)xrow_ptr(base_ctx, base_lat, r0) + lane;
#pragma unroll
        for (int j = 0; j < 4; ++j) nv[j] = xn[64 * j]; }
    for (int row = r0; row < r1; ++row) {
        const int s = row_stream(row);
        if (s != cur_s) { cur_s = s;
#pragma unroll
            for (int j = 0; j < 4; ++j) { const int c = 4 * lane + 256 * j; const f32x4 g = *(const f32x4*)(gain + c); const f32x4 sc = *(const f32x4*)(modl + (size_t)s * 6144 + sc_idx * 1024 + c);
                gm[j] = g * (sc + 1.0f); sh[j] = *(const f32x4*)(modl + (size_t)s * 6144 + sh_idx * 1024 + c); } }
        f32x4 v[4]; float ss = 0.f;
#pragma unroll
        for (int j = 0; j < 4; ++j) v[j] = nv[j];
        { const int rn = (row + 1 < r1) ? row + 1 : row; const f32x4* xn = (const f32x4*)xrow_ptr(base_ctx, base_lat, rn) + lane;
#pragma unroll
          for (int j = 0; j < 4; ++j) nv[j] = xn[64 * j]; }
#pragma unroll
        for (int j = 0; j < 4; ++j) ss += (v[j][0] * v[j][0] + v[j][1] * v[j][1]) + (v[j][2] * v[j][2] + v[j][3] * v[j][3]);
        const float rs = __builtin_amdgcn_rsqf(wave_sum(ss) * (1.0f / D) + EPS);
        u32x2* o = (u32x2*)(H + (size_t)row * D) + lane;
#pragma unroll
        for (int j = 0; j < 4; ++j) { const f32x4 y = v[j] * rs * gm[j] + sh[j]; u32x2 w; w.x = pk_f16(y[0], y[1]); w.y = pk_f16(y[2], y[3]); o[64 * j] = w; }
    }
}
__device__ __forceinline__ void final_norm_phase(float* X, const float* gain, int gw, int ngw, int lane) {
    f32x4 g[4];
#pragma unroll
    for (int j = 0; j < 4; ++j) g[j] = *(const f32x4*)(gain + 4 * lane + 256 * j);
    for (int row = gw; row < M; row += ngw) {
        f32x4* xr = (f32x4*)(X + (size_t)row * D) + lane;
        f32x4 v[4]; float ss = 0.f;
#pragma unroll
        for (int j = 0; j < 4; ++j) { v[j] = xr[64 * j]; ss += (v[j][0] * v[j][0] + v[j][1] * v[j][1]) + (v[j][2] * v[j][2] + v[j][3] * v[j][3]); }
        const float rs = __builtin_amdgcn_rsqf(wave_sum(ss) * (1.0f / D) + EPS);
#pragma unroll
        for (int j = 0; j < 4; ++j) xr[64 * j] = v[j] * rs * g[j];
    }
}

constexpr int SA_RH = 0, SA_KRH = 2304, SA_KNH = 4608, SA_WD = 6912, SA_AD = 9216, SA_GD = 11520, SA_SZ = 15872;
constexpr int L_SA = 0, L_VT = 31744, L_VS = 39424, L_AREF = 46336, L_RREF = 48640, L_BREF = 50944, L_KREF = 53248, L_A0T = 55552, L_R0 = 60672, L_BKT = 65280, L_EC = 75520,
              L_GF = 76032, L_BONP = 84736, L_AAB = 85248, L_AAK = 87296, L_UVT = 87808, L_APR = 92928, L_ARK = 95232, L_YO = 96512, L_MU = 100864, L_DIR = 102656;
static_assert(L_DIR <= LDS_BYTES, "scan LDS");
constexpr int HLD = 72;
constexpr int GD_LD = 136;
constexpr int TLD = 20;

#define FMAC_BC(acc, x, s, N) asm("v_fmac_f32_dpp %0, %1, %2 row_newbcast:" #N " row_mask:0xf bank_mask:0xf" : "+v"(acc) : "v"(x), "v"(s))
#define FS_COL(s) _Pragma("unroll") for (int t_ = s + 1; t_ < 16; ++t_) FMAC_BC(x[t_], arow[t_], x[s], s);
__device__ __forceinline__ void fwd_subst(float (&x)[16], const float (&arow)[16]) {
    FS_COL(0) FS_COL(1) FS_COL(2) FS_COL(3) FS_COL(4) FS_COL(5) FS_COL(6) FS_COL(7) FS_COL(8) FS_COL(9) FS_COL(10) FS_COL(11) FS_COL(12) FS_COL(13) FS_COL(14)
}
__device__ __forceinline__ float fast_tanh(float x) { return 1.0f - 2.0f * __builtin_amdgcn_rcpf(1.0f + __expf(2.0f * x)); }
template <int CTRL> __device__ __forceinline__ float dpp_f(float x) { return __builtin_bit_cast(float, __builtin_amdgcn_update_dpp(0, __builtin_bit_cast(int, x), CTRL, 0xf, 0xf, false)); }
__device__ __forceinline__ float red16(float v) { v += dpp_f<0x128>(v); v += dpp_f<0x124>(v); v += dpp_f<0x122>(v); v += dpp_f<0x121>(v); return v; }
__device__ __forceinline__ float h2f(unsigned short u) { return (float)__builtin_bit_cast(f16, u); }
__device__ __forceinline__ f32x4 tile_xyT(LAS unsigned char* X, LAS unsigned char* Y, int lane) {
    f32x4 acc = {0.f, 0.f, 0.f, 0.f};
    const int o = ((lane & 15) * HLD + 8 * (lane >> 4)) * 2;
#pragma unroll
    for (int ks = 0; ks < 2; ++ks) { const f16x8 fa = *(const LAS f16x8*)(X + o + 64 * ks), fb = *(const LAS f16x8*)(Y + o + 64 * ks); acc = __builtin_amdgcn_mfma_f32_16x16x32_f16(fa, fb, acc, 0, 0, 0); }
    return acc;
}

template <bool LAT> struct PreZ { u32x2 ctr[7]; u32x2 nbr[7]; };

template <bool LAT> __device__ __forceinline__ bool nbr_valid(int t, int q) {
    constexpr int T = LAT ? TLAT : TCTX;
    if (LAT) { const int col = t & 63, rw = t >> 6; return q == 0 ? col >= 1 : (q == 1 ? col < 63 : (q == 2 ? rw >= 1 : rw < 63)); }
    return (q & 1) ? (t + 1 < T) : (t >= 1);
}
template <bool LAT> __device__ __forceinline__ void pre_issue(PreZ<LAT>& P, const f16* Zr, size_t row_base, int c, int d, int h, int tg, bool want_g) {
    const int s = tg >> 4, g = tg & 15, q = g >> 2;
    const int t = 16 * c + (d ? 15 - s : s);
    const unsigned rowoff = (unsigned)((row_base + t) * (size_t)ZRN * 2 + 8 * g);
    const unsigned colb[7] = {(unsigned)(h * 128), (unsigned)(2048 + h * 128), (unsigned)(4096 + h * 128), (unsigned)(6144 + d * 128), (unsigned)(6400 + d * 128), 6656u, 6784u};
    const char* zb = (const char*)Zr;
    constexpr unsigned RS = ZRN * 2;
    unsigned dn;
    if (LAT) dn = q == 0 ? 0u - RS : (q == 1 ? RS : (q == 2 ? 0u - 64u * RS : 64u * RS));
    else dn = (q & 1) ? RS : 0u - RS;
    if (!nbr_valid<LAT>(t, q)) dn = 0u;
#pragma unroll
    for (int a = 0; a < 7; ++a) { const unsigned o = rowoff + colb[a];
        if (a >= 5 && !want_g) continue;
        P.ctr[a] = *(const u32x2*)(zb + o);
        P.nbr[a] = *(const u32x2*)(zb + (o + dn)); }
}
typedef _Float16 h2_t __attribute__((ext_vector_type(2)));
template <bool LAT> __device__ __forceinline__ u32x2 pre_mix(const PreZ<LAT>& P, int a, const u32x2 mu, bool valid) {
    const unsigned cx_ = P.ctr[a][0], cy_ = P.ctr[a][1], nx_ = valid ? P.nbr[a][0] : 0u, ny_ = valid ? P.nbr[a][1] : 0u, mx_ = mu[0], my_ = mu[1];
    const h2_t z0 = __builtin_bit_cast(h2_t, cx_);
    const h2_t z1 = __builtin_bit_cast(h2_t, cy_);
    const h2_t n0 = __builtin_bit_cast(h2_t, nx_);
    const h2_t n1 = __builtin_bit_cast(h2_t, ny_);
    const h2_t m0 = __builtin_bit_cast(h2_t, mx_);
    const h2_t m1 = __builtin_bit_cast(h2_t, my_);
    const h2_t r0 = z0 + m0 * (n0 - z0);
    const h2_t r1 = z1 + m1 * (n1 - z1);
    u32x2 r; r[0] = __builtin_bit_cast(unsigned, r0); r[1] = __builtin_bit_cast(unsigned, r1); return r;
}

template <bool LAT> __device__ __forceinline__ void scan_chain(const Args& a, int z, int l, LAS unsigned char* lds, int unit, int b, int h, int d, int tid, int wave, int lane, const unsigned* mid_cnt = nullptr) {
    constexpr int T = LAT ? TLAT : TCTX, NT = T / 16;
    const size_t row_base = LAT ? (size_t)MCTX + (size_t)b * TLAT : (size_t)b * TCTX;
    const f16* Zr = (const f16*)(a.ws + WS_BIG);
    f16* YA = l == 0 ? (f16*)a.out : (f16*)(a.ws + WS_B);
    float* BONG = (float*)(a.ws + WS_BON);
    unsigned* flag_mine = (unsigned*)(a.ws + WS_CTL) + 1024 + (((size_t)l * 576 + unit) * 2 + d) * 16;
    unsigned* flag_partner = (unsigned*)(a.ws + WS_CTL) + 1024 + (((size_t)l * 576 + unit) * 2 + (d ^ 1)) * 16;
    const bool helper = wave >= 4;
    const int q = wave & 3, tg = tid & 255, g4 = lane >> 4, c16 = lane & 15;
    LAS unsigned char* Ld = lds;
    const unsigned char* sm = a.ws + WS_SMALL;
    const int jl = 16 * q + c16;
    const int lcol = h * 64 + perm_o(jl), kq = 8 * g4;
    const f16* gu = (const f16*)(sm + SM_GUP) + ((size_t)l * 1024 + lcol) * 128 + kq;
    const f16* wu = (const f16*)(sm + SM_WUP) + ((size_t)(l * 2 + d) * 1024 + lcol) * 64 + kq;
    const f16* au = (const f16*)(sm + SM_AUP) + ((size_t)(l * 2 + d) * 1024 + lcol) * 64 + kq;
    const float* w0p = a.in[z + I_W0] + (size_t)(l * 2 + d) * 1024 + lcol; const float* a0p = a.in[z + I_A0] + (size_t)(l * 2 + d) * 1024 + lcol;
    const float* kap = a.in[z + I_KA] + l * 1024 + lcol; const float* rkp = a.in[z + I_RK] + l * 1024 + lcol;
    const int sA = tg >> 4, gA = tg & 15;
    const int chA = h * 64 + 4 * gA;
    if (helper && sA == 0) {
        const float* mu = a.in[z + I_MU] + (size_t)l * CRW;
        const int colbase[7] = {h * 64 + 4 * gA, 1024 + h * 64 + 4 * gA, 2048 + h * 64 + 4 * gA, 3072 + d * 64 + 4 * gA, 3200 + d * 64 + 4 * gA, 3328 + 4 * gA, 3392 + 4 * gA};
#pragma unroll
        for (int i = 0; i < 7; ++i) { const float* mb = mu + (colbase[i] - 4 * gA);
            u32x2 w; w.x = pk_f16(mb[perm_o(4 * gA)], mb[perm_o(4 * gA + 1)]); w.y = pk_f16(mb[perm_o(4 * gA + 2)], mb[perm_o(4 * gA + 3)]); *(LAS u32x2*)(Ld + L_MU + (i * 64 + 4 * gA) * 2) = w; }
    }
#define MUV(i) (*(const LAS u32x2*)(Ld + L_MU + ((i) * 64 + 4 * gA) * 2))
    f32x4 kkc4, lng4, lnb4;
#pragma unroll
    for (int e = 0; e < 4; ++e) { const int co = l * 1024 + h * 64 + perm_o(4 * gA + e); kkc4[e] = a.in[z + I_KK][co]; lng4[e] = a.in[z + I_LNXG][co]; lnb4[e] = a.in[z + I_LNXB][co]; }
    const unsigned kkw0_ = pk_f16(kkc4[0], kkc4[1]), kkw1_ = pk_f16(kkc4[2], kkc4[3]);
    const h2_t kkh0 = __builtin_bit_cast(h2_t, kkw0_);
    const h2_t kkh1 = __builtin_bit_cast(h2_t, kkw1_);
    float S[16];
    const size_t sidx = ((((size_t)b * 2 + l) * 2 + d) * 16 + h) * 4096 + (size_t)perm_o(16 * q + c16) * 64;
    if (LAT && !helper) { const float* sp = a.in[z + I_STATE] + sidx;
#pragma unroll
        for (int n = 0; n < 16; ++n) S[n] = sp[perm_o(32 * (n >> 3) + 8 * g4 + (n & 7))]; }
    else {
#pragma unroll
        for (int n = 0; n < 16; ++n) S[n] = 0.f; }
    for (int i = tid; i < 5120 / 4; i += NTHR) { *(LAS unsigned*)(Ld + L_BKT + 5120 + 4 * i) = 0u; *(LAS unsigned*)(Ld + L_UVT + 4 * i) = 0u; }
    for (int i = tid; i < 2304 / 4; i += NTHR) { *(LAS unsigned*)(Ld + L_R0 + 2304 + 4 * i) = 0u; *(LAS unsigned*)(Ld + L_APR + 4 * i) = 0u; }
    for (int i = tid; i < 1280 / 4; i += NTHR) *(LAS unsigned*)(Ld + L_ARK + 4 * i) = 0u;
    for (int i = tid; i < 2560 / 4; i += NTHR) *(LAS unsigned*)(Ld + L_VT + 2 * 2560 + 4 * i) = 0u;
    if (tid < 64) *(LAS float*)(Ld + L_EC + 256 + 4 * tid) = 1.0f;
    __syncthreads();
    PreZ<LAT> PA, PB;
    u32x2 yprev = {0u, 0u}; float bgprev = 0.f; bool flag_ok = false;

#define STAGE_A(nA, PX) do { const int cA_ = d ? NT - 1 - (nA) : (nA); const int vb = (nA) % 3; LAS unsigned char* SAw = Ld + L_SA + ((nA) & 1) * SA_SZ; const int tA = 16 * cA_ + (d ? 15 - sA : sA); const bool vA = nbr_valid<LAT>(tA, gA >> 2); \
            const u32x2 zr = pre_mix<LAT>(PX, 0, MUV(0), vA), zk = pre_mix<LAT>(PX, 1, MUV(1), vA), zv = pre_mix<LAT>(PX, 2, MUV(2), vA), zw = pre_mix<LAT>(PX, 3, MUV(3), vA), za = pre_mix<LAT>(PX, 4, MUV(4), vA); \
            const int o8 = (sA * HLD + 4 * gA) * 2; \
            *(LAS u32x2*)(SAw + SA_RH + o8) = zr; \
            *(LAS u32x2*)(SAw + SA_KRH + o8) = zk; \
            { const unsigned zk0_ = zk[0], zk1_ = zk[1]; const h2_t k0 = __builtin_bit_cast(h2_t, zk0_) * kkh0; const h2_t k1 = __builtin_bit_cast(h2_t, zk1_) * kkh1; \
              const float ss = red16(__builtin_amdgcn_fdot2(k0, k0, __builtin_amdgcn_fdot2(k1, k1, 0.f, false), false)); const float rn = __builtin_amdgcn_rsqf(ss + 1e-12f); \
              u32x2 w; w.x = pk_f16((float)k0.x * rn, (float)k0.y * rn); w.y = pk_f16((float)k1.x * rn, (float)k1.y * rn); *(LAS u32x2*)(SAw + SA_KNH + o8) = w; } \
            { const u32x2 w = zv; *(LAS u32x2*)(Ld + L_VS + vb * 2304 + o8) = w; \
              *(LAS unsigned short*)(Ld + L_VT + vb * 2560 + ((4 * gA + 0) * TLD + sA) * 2) = (unsigned short)(w.x & 0xffffu); *(LAS unsigned short*)(Ld + L_VT + vb * 2560 + ((4 * gA + 1) * TLD + sA) * 2) = (unsigned short)(w.x >> 16); \
              *(LAS unsigned short*)(Ld + L_VT + vb * 2560 + ((4 * gA + 2) * TLD + sA) * 2) = (unsigned short)(w.y & 0xffffu); *(LAS unsigned short*)(Ld + L_VT + vb * 2560 + ((4 * gA + 3) * TLD + sA) * 2) = (unsigned short)(w.y >> 16); } \
            { u32x2 w; w.x = pk_f16(fast_tanh(f16lo(zw.x)), fast_tanh(f16hi(zw.x))); w.y = pk_f16(fast_tanh(f16lo(zw.y)), fast_tanh(f16hi(zw.y))); *(LAS u32x2*)(SAw + SA_WD + o8) = w; } \
            *(LAS u32x2*)(SAw + SA_AD + o8) = za; \
            if ((nA) >= NT / 2) { \
                const u32x2 g0 = pre_mix<LAT>(PX, 5, MUV(5), vA), g1 = pre_mix<LAT>(PX, 6, MUV(6), vA); \
                u32x2 w; w.x = pk_f16(fast_sigmoid(f16lo(g0.x)), fast_sigmoid(f16hi(g0.x))); w.y = pk_f16(fast_sigmoid(f16lo(g0.y)), fast_sigmoid(f16hi(g0.y))); *(LAS u32x2*)(SAw + SA_GD + (sA * GD_LD + 4 * gA) * 2) = w; \
                w.x = pk_f16(fast_sigmoid(f16lo(g1.x)), fast_sigmoid(f16hi(g1.x))); w.y = pk_f16(fast_sigmoid(f16lo(g1.y)), fast_sigmoid(f16hi(g1.y))); *(LAS u32x2*)(SAw + SA_GD + (sA * GD_LD + 64 + 4 * gA) * 2) = w; \
            } } while (0)
#define FINALIZE(nF) do { const bool finp = ((nF) >= NT / 2); const int cp = d ? NT - 1 - (nF) : (nF); const int pb = (nF) & 1; const int v3 = (nF) % 3; \
            const size_t row = row_base + (size_t)(16 * cp + (d ? 15 - sA : sA)); \
            const f32x4 yv = *(const LAS f32x4*)(Ld + L_YO + (sA * 68 + 4 * gA) * 4); \
            LAS unsigned char* bp = Ld + L_BONP + pb * 256; \
            const float bon = *(LAS float*)(bp + (0 * 16 + sA) * 4) + *(LAS float*)(bp + (1 * 16 + sA) * 4) + *(LAS float*)(bp + (2 * 16 + sA) * 4) + *(LAS float*)(bp + (3 * 16 + sA) * 4); \
            unsigned long long* yp = (unsigned long long*)(YA + row * D + chA); \
            if (!finp) { const unsigned long long w = (unsigned long long)pk_f16(yv[0], yv[1]) | ((unsigned long long)pk_f16(yv[2], yv[3]) << 32); \
                __hip_atomic_store(yp, w, __ATOMIC_RELAXED, __HIP_MEMORY_SCOPE_AGENT); if (gA == 0) __hip_atomic_store(BONG + row * 16 + h, bon, __ATOMIC_RELAXED, __HIP_MEMORY_SCOPE_AGENT); } \
            else { \
                const f32x4 y = {yv[0] + f16lo(yprev.x), yv[1] + f16hi(yprev.x), yv[2] + f16lo(yprev.y), yv[3] + f16hi(yprev.y)}; \
                const float mean = red16((y[0] + y[1]) + (y[2] + y[3])) * (1.0f / 64.0f); const f32x4 dv = y - mean; \
                const float var = red16((dv[0] * dv[0] + dv[1] * dv[1]) + (dv[2] * dv[2] + dv[3] * dv[3])) * (1.0f / 64.0f); \
                const f32x4 yn = dv * __builtin_amdgcn_rsqf(var + GN_EPS) * lng4 + lnb4; \
                const u32x2 vw = *(const LAS u32x2*)(Ld + L_VS + v3 * 2304 + (sA * HLD + 4 * gA) * 2); const f32x4 vv = {f16lo(vw.x), f16hi(vw.x), f16lo(vw.y), f16hi(vw.y)}; \
                const f32x4 gg = *(const LAS f32x4*)(Ld + L_GF + pb * 4352 + (sA * 68 + 4 * gA) * 4); \
                const f32x4 o = (yn + (bon + bgprev) * vv) * gg; \
                u32x2 w; w.x = pk_f16(o[0], o[1]); w.y = pk_f16(o[2], o[3]); *(u32x2*)yp = w; \
            } } while (0)

    if (helper) {
        pre_issue<LAT>(PA, Zr, row_base, d ? NT - 1 : 0, d, h, tg, NT / 2 <= 0);
        pre_issue<LAT>(PB, Zr, row_base, d ? NT - 2 : 1, d, h, tg, NT / 2 <= 1);
        STAGE_A(0, PA);
        pre_issue<LAT>(PA, Zr, row_base, d ? NT - 3 : 2, d, h, tg, NT / 2 <= 2);
        bool have_prev = false;
        __syncthreads();
#pragma unroll 1
        for (int n2_ = 0; n2_ < NT / 2; ++n2_) {
            int n2 = n2_; asm volatile("" : "+v"(n2)); n2 = __builtin_amdgcn_readfirstlane(n2);
#pragma unroll
        for (int par_ = 0; par_ < 2; ++par_) {
            const int n = 2 * n2 + par_;
            if (tid == 256 && n == NT / 2 + 1) __hip_atomic_store(flag_mine, (unsigned)(NT / 2), __ATOMIC_RELAXED, __HIP_MEMORY_SCOPE_AGENT);
            if (n + 1 < NT) { if (par_ == 0) STAGE_A(n + 1, PB); else STAGE_A(n + 1, PA); }
            __syncthreads();
            if (n > 0) {
                if (n - 1 >= NT / 2 && !have_prev) {
                    const int mP = n - 1;
                    if (!flag_ok) { unsigned spins = 0; while (__hip_atomic_load(flag_partner, __ATOMIC_RELAXED, __HIP_MEMORY_SCOPE_AGENT) < (unsigned)(NT / 2)) { __builtin_amdgcn_s_sleep(4); if (++spins > (1u << 22)) break; }
                        __builtin_amdgcn_fence(__ATOMIC_ACQUIRE, "agent"); flag_ok = true; }
                    const size_t rowp_ = row_base + (size_t)(16 * (d ? NT - 1 - mP : mP) + (d ? 15 - sA : sA));
                    const unsigned long long wq_ = __hip_atomic_load((const unsigned long long*)(YA + rowp_ * D + chA), __ATOMIC_RELAXED, __HIP_MEMORY_SCOPE_AGENT);
                    yprev.x = (unsigned)wq_; yprev.y = (unsigned)(wq_ >> 32);
                    bgprev = __hip_atomic_load(BONG + rowp_ * 16 + h, __ATOMIC_RELAXED, __HIP_MEMORY_SCOPE_AGENT);
                }
                FINALIZE(n - 1);
                if (n == NT / 2) asm volatile("s_waitcnt vmcnt(0)" ::: "memory");
            }
            have_prev = false;
            if (n >= NT / 2 && flag_ok) {
                    const int mP = n;
                    const size_t rowp_ = row_base + (size_t)(16 * (d ? NT - 1 - mP : mP) + (d ? 15 - sA : sA));
                    const unsigned long long wq_ = __hip_atomic_load((const unsigned long long*)(YA + rowp_ * D + chA), __ATOMIC_RELAXED, __HIP_MEMORY_SCOPE_AGENT);
                    yprev.x = (unsigned)wq_; yprev.y = (unsigned)(wq_ >> 32);
                    bgprev = __hip_atomic_load(BONG + rowp_ * 16 + h, __ATOMIC_RELAXED, __HIP_MEMORY_SCOPE_AGENT);
                    have_prev = true; }
            asm volatile("" ::: "memory");
            if (LAT && mid_cnt != nullptr && (n + 3 == 28 || n + 3 == 60 || n + 3 == 92)) {
                const unsigned* cw = mid_cnt + (n + 3 == 28 ? 0 : (n + 3 == 60 ? 64 : 128));
                unsigned spins = 0; while (__hip_atomic_load(cw, __ATOMIC_RELAXED, __HIP_MEMORY_SCOPE_AGENT) < 128u) { __builtin_amdgcn_s_sleep(8); if (++spins > (1u << 22)) break; }
                __builtin_amdgcn_fence(__ATOMIC_ACQUIRE, "agent"); }
            { const int nn = (n + 3 < NT) ? n + 3 : NT - 1;
              if (par_ == 0) pre_issue<LAT>(PB, Zr, row_base, d ? NT - 1 - nn : nn, d, h, tg, nn >= NT / 2); else pre_issue<LAT>(PA, Zr, row_base, d ? NT - 1 - nn : nn, d, h, tg, nn >= NT / 2); }
            __syncthreads();
        }
        }
        __syncthreads();
        if (!have_prev) {
                    const int mP = NT - 1;
                    if (!flag_ok) { unsigned spins = 0; while (__hip_atomic_load(flag_partner, __ATOMIC_RELAXED, __HIP_MEMORY_SCOPE_AGENT) < (unsigned)(NT / 2)) { __builtin_amdgcn_s_sleep(4); if (++spins > (1u << 22)) break; }
                        __builtin_amdgcn_fence(__ATOMIC_ACQUIRE, "agent"); flag_ok = true; }
                    const size_t rowp_ = row_base + (size_t)(16 * (d ? NT - 1 - mP : mP) + (d ? 15 - sA : sA));
                    const unsigned long long wq_ = __hip_atomic_load((const unsigned long long*)(YA + rowp_ * D + chA), __ATOMIC_RELAXED, __HIP_MEMORY_SCOPE_AGENT);
                    yprev.x = (unsigned)wq_; yprev.y = (unsigned)(wq_ >> 32);
                    bgprev = __hip_atomic_load(BONG + rowp_ * 16 + h, __ATOMIC_RELAXED, __HIP_MEMORY_SCOPE_AGENT);
        }
        FINALIZE(NT - 1);
    } else {
        __builtin_amdgcn_s_setprio(2);
        f16x8 wupB[2], aupB[2], gupB[4];
#pragma unroll
        for (int ks = 0; ks < 2; ++ks) { wupB[ks] = *(const f16x8*)(wu + 32 * ks); aupB[ks] = *(const f16x8*)(au + 32 * ks); }
#pragma unroll
        for (int ks = 0; ks < 4; ++ks) gupB[ks] = *(const f16x8*)(gu + 32 * ks);
        const float w0v = *w0p, a0v = *a0p, kac = *kap, rkc = *rkp;
        __syncthreads();
#pragma unroll 1
        for (int n_ = 0; n_ < NT; ++n_) {
            int n = n_; asm volatile("" : "+v"(n)); n = __builtin_amdgcn_readfirstlane(n);
            const bool fin = (n >= NT / 2);
            const int pbn = n & 1, v3n = n % 3;
            LAS unsigned char* SAb = Ld + L_SA + pbn * SA_SZ;
            {
            const int pbm = (n + 1) & 1, v3m = (n + 2) % 3;
            f16x8 sb[2];
#pragma unroll
            for (int ks = 0; ks < 2; ++ks) { u32x4 w; w.x = pk_f16(S[8 * ks], S[8 * ks + 1]); w.y = pk_f16(S[8 * ks + 2], S[8 * ks + 3]); w.z = pk_f16(S[8 * ks + 4], S[8 * ks + 5]); w.w = pk_f16(S[8 * ks + 6], S[8 * ks + 7]); sb[ks] = __builtin_bit_cast(f16x8, w); }
            const int il = 16 * q + c16;
            f32x4 U = *(const LAS f32x4*)(Ld + L_UVT + (il * TLD + 4 * g4) * 4);
            f32x4 Y = {0.f, 0.f, 0.f, 0.f};
            const int oa = (c16 * HLD + 8 * g4) * 2;
#pragma unroll
            for (int ks = 0; ks < 2; ++ks) {
                const f16x8 fap = *(const LAS f16x8*)(Ld + L_APR + oa + 64 * ks), fr0 = *(const LAS f16x8*)(Ld + L_R0 + pbm * 2304 + oa + 64 * ks);
                U = __builtin_amdgcn_mfma_f32_16x16x32_f16(fap, sb[ks], U, 0, 0, 0);
                Y = __builtin_amdgcn_mfma_f32_16x16x32_f16(fr0, sb[ks], Y, 0, 0, 0);
            }
            f16x8 uvb; { const u32x2 wv_ = *(const LAS u32x2*)(Ld + L_VT + v3m * 2560 + (il * TLD + 4 * g4) * 2); const u32x4 w4 = {pk_f16(U[0], U[1]), pk_f16(U[2], U[3]), wv_.x, wv_.y}; uvb = __builtin_bit_cast(f16x8, w4); }
            { const f16x8 fark = *(const LAS f16x8*)(Ld + L_ARK + (c16 * 40 + 8 * g4) * 2); Y = __builtin_amdgcn_mfma_f32_16x16x32_f16(fark, uvb, Y, 0, 0, 0); }
#pragma unroll
            for (int r = 0; r < 4; ++r) *(LAS float*)(Ld + L_YO + ((4 * g4 + r) * 68 + il) * 4) = Y[r];
#pragma unroll
            for (int jt = 0; jt < 4; ++jt) {
                const int jo = 32 * (jt >> 1) + 8 * (c16 >> 2) + 4 * (jt & 1) + (c16 & 3);
                const f16x8 fbk = *(const LAS f16x8*)(Ld + L_BKT + pbm * 5120 + (jo * 40 + 8 * g4) * 2);
                const f32x4 ec = *(const LAS f32x4*)(Ld + L_EC + pbm * 256 + (32 * (jt >> 1) + 8 * g4 + 4 * (jt & 1)) * 4);
                const int sbase = 8 * (jt >> 1) + 4 * (jt & 1);
                f32x4 cin = {S[sbase] * ec[0], S[sbase + 1] * ec[1], S[sbase + 2] * ec[2], S[sbase + 3] * ec[3]};
                cin = __builtin_amdgcn_mfma_f32_16x16x32_f16(fbk, uvb, cin, 0, 0, 0);
                S[sbase] = cin[0]; S[sbase + 1] = cin[1]; S[sbase + 2] = cin[2]; S[sbase + 3] = cin[3];
            }
            }
            {
            f32x4 cw = {0.f, 0.f, 0.f, 0.f}, ca = {0.f, 0.f, 0.f, 0.f};
#pragma unroll
            for (int ks = 0; ks < 2; ++ks) {
                const f16x8 fw = *(const LAS f16x8*)(SAb + SA_WD + (c16 * HLD + kq + 32 * ks) * 2);
                const f16x8 fa = *(const LAS f16x8*)(SAb + SA_AD + (c16 * HLD + kq + 32 * ks) * 2);
                cw = __builtin_amdgcn_mfma_f32_16x16x32_f16(fw, wupB[ks], cw, 0, 0, 0);
                ca = __builtin_amdgcn_mfma_f32_16x16x32_f16(fa, aupB[ks], ca, 0, 0, 0);
            }
            if (fin) {
                f32x4 cg_ = {0.f, 0.f, 0.f, 0.f};
#pragma unroll
                for (int ks = 0; ks < 4; ++ks) { const f16x8 fg = *(const LAS f16x8*)(SAb + SA_GD + (c16 * GD_LD + kq + 32 * ks) * 2); cg_ = __builtin_amdgcn_mfma_f32_16x16x32_f16(fg, gupB[ks], cg_, 0, 0, 0); }
#pragma unroll
                for (int r = 0; r < 4; ++r) *(LAS float*)(Ld + L_GF + pbn * 4352 + ((4 * g4 + r) * 68 + jl) * 4) = cg_[r];
            }
            float wv[4], av[4], rr[4], kd[4], kn[4];
#pragma unroll
            for (int r = 0; r < 4; ++r) { const int o = ((4 * g4 + r) * HLD + jl) * 2;
                wv[r] = __expf(-DECAY_SCALE * fast_sigmoid(w0v + cw[r])); av[r] = fast_sigmoid(a0v + ca[r]);
                rr[r] = (float)*(LAS f16*)(SAb + SA_RH + o); const float kr = (float)*(LAS f16*)(SAb + SA_KRH + o); kn[r] = (float)*(LAS f16*)(SAb + SA_KNH + o);
                kd[r] = kr * (1.0f + (av[r] - 1.0f) * kac); }
            float E[4]; E[0] = wv[0]; E[1] = E[0] * wv[1]; E[2] = E[1] * wv[2]; E[3] = E[2] * wv[3];
            float tt = E[3];
            { const float u1 = __shfl_up(tt, 16); if (g4 >= 1) tt *= u1; const float u2 = __shfl_up(tt, 32); if (g4 >= 2) tt *= u2; }
            float ex = __shfl_up(tt, 16); if (g4 == 0) ex = 1.0f;
            const float EC = __shfl(tt, 48 + c16), Emid = __shfl(tt, 16 + c16);
            const float c1 = __builtin_amdgcn_rcpf(Emid), c2 = Emid;
            float bonp[4]; float a0t[4]; unsigned short hBp[4], hKp[4];
#pragma unroll
            for (int r = 0; r < 4; ++r) {
                const float Ei = ex * E[r], Ep = (r == 0) ? ex : ex * E[r - 1], inv = __builtin_amdgcn_rcpf(Ei);
                const float aa = -kn[r], bb = av[r] * kn[r];
                a0t[r] = aa * Ep;
                hBp[r] = __builtin_bit_cast(unsigned short, (f16)(bb * inv * EC)); hKp[r] = __builtin_bit_cast(unsigned short, (f16)(kd[r] * inv * EC));
                bonp[r] = red16(kd[r] * rkc * rr[r]);
                const int o = ((4 * g4 + r) * HLD + jl) * 2;
                *(LAS f16*)(Ld + L_AREF + o) = (f16)(a0t[r] * c1); *(LAS f16*)(Ld + L_RREF + o) = (f16)(rr[r] * Ei * c1); *(LAS f16*)(Ld + L_BREF + o) = (f16)(bb * inv * c2); *(LAS f16*)(Ld + L_KREF + o) = (f16)(kd[r] * inv * c2);
                *(LAS f16*)(Ld + L_R0 + pbn * 2304 + o) = (f16)(rr[r] * Ei);
            }
            *(LAS f32x4*)(Ld + L_A0T + (jl * TLD + 4 * g4) * 4) = (f32x4){a0t[0], a0t[1], a0t[2], a0t[3]};
            { u32x4 w; w.x = hBp[0] | ((unsigned)hBp[1] << 16); w.y = hBp[2] | ((unsigned)hBp[3] << 16); w.z = hKp[0] | ((unsigned)hKp[1] << 16); w.w = hKp[2] | ((unsigned)hKp[3] << 16);
              *(LAS u32x4*)(Ld + L_BKT + pbn * 5120 + (jl * 40 + 8 * g4) * 2) = w; }
            if (g4 == 0) *(LAS float*)(Ld + L_EC + pbn * 256 + jl * 4) = EC;
            if (c16 == 0) {
#pragma unroll
                for (int r = 0; r < 4; ++r) *(LAS float*)(Ld + L_BONP + pbn * 256 + (q * 16 + 4 * g4 + r) * 4) = bonp[r]; }
            }
            __syncthreads();
            {
            if (q == 0) {
                const f32x4 ab = tile_xyT(Ld + L_AREF, Ld + L_BREF, lane);
#pragma unroll
                for (int r = 0; r < 4; ++r) *(LAS float*)(Ld + L_AAB + ((4 * g4 + r) * 16 + c16) * 4) = ab[r];
                float x[16], arow[16];
#pragma unroll
                for (int t4 = 0; t4 < 4; ++t4) { const f32x4 v = *(const LAS f32x4*)(Ld + L_A0T + (lane * TLD + 4 * t4) * 4); x[4 * t4] = v[0]; x[4 * t4 + 1] = v[1]; x[4 * t4 + 2] = v[2]; x[4 * t4 + 3] = v[3]; }
#pragma unroll
                for (int t = 0; t < 16; ++t) arow[t] = *(LAS float*)(Ld + L_AAB + (t * 16 + c16) * 4);
                fwd_subst(x, arow);
#pragma unroll
                for (int t = 0; t < 16; ++t) *(LAS f16*)(Ld + L_APR + (t * HLD + lane) * 2) = (f16)x[t];
            } else if (q == 1) {
                const f32x4 ab = tile_xyT(Ld + L_AREF, Ld + L_BREF, lane);
                const f32x4 ak = tile_xyT(Ld + L_AREF, Ld + L_KREF, lane);
#pragma unroll
                for (int r = 0; r < 4; ++r) { const int t = 4 * g4 + r; *(LAS float*)(Ld + L_AAB + 1024 + (t * 16 + c16) * 4) = ab[r]; *(LAS f16*)(Ld + L_AAK + (t * 16 + c16) * 2) = (f16)((c16 < t) ? ak[r] : 0.f); }
                f16x8 fa; { const u32x2 w = *(const LAS u32x2*)(Ld + L_AAK + (c16 * 16 + 4 * g4) * 2); const u32x4 w4 = {w.x, w.y, 0u, 0u}; fa = __builtin_bit_cast(f16x8, w4); }
#pragma unroll
                for (int it = 0; it < 4; ++it) {
                    const u32x2 wv_ = *(const LAS u32x2*)(Ld + L_VT + v3n * 2560 + ((16 * it + c16) * TLD + 4 * g4) * 2); const u32x4 w4 = {wv_.x, wv_.y, 0u, 0u};
                    f32x4 acc = {0.f, 0.f, 0.f, 0.f};
                    acc = __builtin_amdgcn_mfma_f32_16x16x32_f16(fa, __builtin_bit_cast(f16x8, w4), acc, 0, 0, 0);
                    *(LAS f32x4*)(Ld + L_UVT + ((16 * it + c16) * TLD + 4 * g4) * 4) = acc;
                }
                float x[16], arow[16];
#pragma unroll
                for (int t4 = 0; t4 < 4; ++t4) { const f32x4 v = *(const LAS f32x4*)(Ld + L_UVT + (lane * TLD + 4 * t4) * 4); x[4 * t4] = v[0]; x[4 * t4 + 1] = v[1]; x[4 * t4 + 2] = v[2]; x[4 * t4 + 3] = v[3]; }
#pragma unroll
                for (int t = 0; t < 16; ++t) arow[t] = *(LAS float*)(Ld + L_AAB + 1024 + (t * 16 + c16) * 4);
                fwd_subst(x, arow);
#pragma unroll
                for (int t4 = 0; t4 < 4; ++t4) *(LAS f32x4*)(Ld + L_UVT + (lane * TLD + 4 * t4) * 4) = (f32x4){x[4 * t4], x[4 * t4 + 1], x[4 * t4 + 2], x[4 * t4 + 3]};
            } else if (q == 2) {
                const f32x4 rb = tile_xyT(Ld + L_RREF, Ld + L_BREF, lane);
                const f32x4 rk = tile_xyT(Ld + L_RREF, Ld + L_KREF, lane);
#pragma unroll
                for (int r = 0; r < 4; ++r) { const int t = 4 * g4 + r; const bool keep = (c16 <= t);
                    *(LAS f16*)(Ld + L_ARK + (t * 40 + 8 * (c16 >> 2) + (c16 & 3)) * 2) = (f16)(keep ? rb[r] : 0.f);
                    *(LAS f16*)(Ld + L_ARK + (t * 40 + 8 * (c16 >> 2) + 4 + (c16 & 3)) * 2) = (f16)(keep ? rk[r] : 0.f); }
            }
            }
            __syncthreads();
        }
        {
            const int n = NT; const int pbn = n & 1; (void)pbn;
            const int pbm = (n - 1) & 1, v3m = (n - 1) % 3;
            f16x8 sb[2];
#pragma unroll
            for (int ks = 0; ks < 2; ++ks) { u32x4 w; w.x = pk_f16(S[8 * ks], S[8 * ks + 1]); w.y = pk_f16(S[8 * ks + 2], S[8 * ks + 3]); w.z = pk_f16(S[8 * ks + 4], S[8 * ks + 5]); w.w = pk_f16(S[8 * ks + 6], S[8 * ks + 7]); sb[ks] = __builtin_bit_cast(f16x8, w); }
            const int il = 16 * q + c16;
            f32x4 U = *(const LAS f32x4*)(Ld + L_UVT + (il * TLD + 4 * g4) * 4);
            f32x4 Y = {0.f, 0.f, 0.f, 0.f};
            const int oa = (c16 * HLD + 8 * g4) * 2;
#pragma unroll
            for (int ks = 0; ks < 2; ++ks) {
                const f16x8 fap = *(const LAS f16x8*)(Ld + L_APR + oa + 64 * ks), fr0 = *(const LAS f16x8*)(Ld + L_R0 + pbm * 2304 + oa + 64 * ks);
                U = __builtin_amdgcn_mfma_f32_16x16x32_f16(fap, sb[ks], U, 0, 0, 0);
                Y = __builtin_amdgcn_mfma_f32_16x16x32_f16(fr0, sb[ks], Y, 0, 0, 0);
            }
            f16x8 uvb; { const u32x2 wv_ = *(const LAS u32x2*)(Ld + L_VT + v3m * 2560 + (il * TLD + 4 * g4) * 2); const u32x4 w4 = {pk_f16(U[0], U[1]), pk_f16(U[2], U[3]), wv_.x, wv_.y}; uvb = __builtin_bit_cast(f16x8, w4); }
            { const f16x8 fark = *(const LAS f16x8*)(Ld + L_ARK + (c16 * 40 + 8 * g4) * 2); Y = __builtin_amdgcn_mfma_f32_16x16x32_f16(fark, uvb, Y, 0, 0, 0); }
#pragma unroll
            for (int r = 0; r < 4; ++r) *(LAS float*)(Ld + L_YO + ((4 * g4 + r) * 68 + il) * 4) = Y[r];
#pragma unroll
            for (int jt = 0; jt < 4; ++jt) {
                const int jo = 32 * (jt >> 1) + 8 * (c16 >> 2) + 4 * (jt & 1) + (c16 & 3);
                const f16x8 fbk = *(const LAS f16x8*)(Ld + L_BKT + pbm * 5120 + (jo * 40 + 8 * g4) * 2);
                const f32x4 ec = *(const LAS f32x4*)(Ld + L_EC + pbm * 256 + (32 * (jt >> 1) + 8 * g4 + 4 * (jt & 1)) * 4);
                const int sbase = 8 * (jt >> 1) + 4 * (jt & 1);
                f32x4 cin = {S[sbase] * ec[0], S[sbase + 1] * ec[1], S[sbase + 2] * ec[2], S[sbase + 3] * ec[3]};
                cin = __builtin_amdgcn_mfma_f32_16x16x32_f16(fbk, uvb, cin, 0, 0, 0);
                S[sbase] = cin[0]; S[sbase + 1] = cin[1]; S[sbase + 2] = cin[2]; S[sbase + 3] = cin[3];
            }
        }
        __builtin_amdgcn_s_setprio(0);
        __syncthreads();
        if (!LAT) { float* sp = a.out + (size_t)M * D + sidx;
#pragma unroll
            for (int n = 0; n < 16; ++n) sp[perm_o(32 * (n >> 3) + 8 * g4 + (n & 7))] = S[n]; }
    }
    __syncthreads();
#undef STAGE_A
#undef FINALIZE
#undef MUV
}
__device__ __forceinline__ void scan_phase(const Args& a, int z, int l, LAS unsigned char* lds, int G, int bx, int tid, int wave, int lane, const unsigned* mid_cnt = nullptr) {
    if (G == 256) {
        const int d = (bx >> 3) & 1, p = (bx & 7) + 8 * (bx >> 4);
        if (p < 64) scan_chain<true>(a, z, l, lds, p, p >> 4, p & 15, d, tid, wave, lane, mid_cnt);
        else for (int u = p - 64; u < 512; u += 64) scan_chain<false>(a, z, l, lds, 64 + u, u >> 4, u & 15, d, tid, wave, lane);
    } else {
        const int d = bx & 1, np = G >> 1;
        if (bx < 2 * np) for (int u = bx >> 1; u < 576; u += np) { if (u < 64) scan_chain<true>(a, z, l, lds, u, u >> 4, u & 15, d, tid, wave, lane); else scan_chain<false>(a, z, l, lds, u, (u - 64) >> 4, (u - 64) & 15, d, tid, wave, lane); }
    }
}

constexpr int MX_LD = 272, MX_TB = 128 * MX_LD, MX_STAT = 2 * MX_TB;
__device__ __forceinline__ f16x4 tr_read(LAS unsigned char* p) { return __builtin_bit_cast(f16x4, __builtin_amdgcn_ds_read_tr16_b64_v4i16((LAS v4i16_t*)p)); }
__device__ __forceinline__ void mix_phase(const Args& a, int z, int l, LAS unsigned char* lds, int G, int bx, int tid, int wave, int lane) {
    f16* U16 = (f16*)(a.ws + WS_BIG + 48 * MiB); const f16* V16 = (const f16*)(a.ws + WS_BIG + 96 * MiB);
    const f16* ws16 = (const f16*)(a.ws + WS_SMALL + SM_WS) + (size_t)l * 8 * 128 * 128;
    const float* lnvg = a.in[z + I_LNVG] + l * 1024; const float* bs = a.in[z + I_BS] + l * 1024;
    LAS float* STAT = (LAS float*)(lds + MX_STAT);
    const int pl = 16 * wave + (lane & 15), g4 = lane >> 4;
    for (int unit = bx; unit < M / 128; unit += G) {
        const size_t r0 = (size_t)unit * 128;
        {
            f16x8 x[4][8];
#pragma unroll
            for (int ps = 0; ps < 4; ++ps) { const f16* p = V16 + (r0 + 16 * wave + 4 * ps + g4) * D + 8 * (lane & 15);
#pragma unroll
                for (int k = 0; k < 8; ++k) x[ps][k] = *(const f16x8*)(p + 128 * k); }
#pragma unroll
            for (int ps = 0; ps < 4; ++ps) { const int q = 16 * wave + 4 * ps + g4;
                float s = 0.f, s2 = 0.f;
#pragma unroll
                for (int k = 0; k < 8; ++k)
#pragma unroll
                    for (int e = 0; e < 8; ++e) { const float v = (float)x[ps][k][e]; s += v; s2 += v * v; }
                s = red16(s); s2 = red16(s2);
                const float mean = s * (1.0f / D); const float var = s2 * (1.0f / D) - mean * mean;
                if ((lane & 15) == 0) { STAT[2 * q] = mean; STAT[2 * q + 1] = __builtin_amdgcn_rsqf((var > 0.f ? var : 0.f) + EPS); } }
        }
        const int qs = tid >> 4, ch = tid & 15;
        f16x8 vreg[4]; u32x2 ureg[8]; f16x8 wfrag[4]; f32x4 gpre0, gpre1;
#define MIX_PREFETCH(hh) do { \
            _Pragma("unroll") for (int i = 0; i < 4; ++i) vreg[i] = *(const f16x8*)(V16 + (r0 + qs + 32 * i) * D + (hh) * 128 + 8 * ch); \
            _Pragma("unroll") for (int ct = 0; ct < 8; ++ct) ureg[ct] = *(const u32x2*)(U16 + (r0 + pl) * D + (hh) * 128 + 16 * ct + 4 * g4); \
            _Pragma("unroll") for (int ks = 0; ks < 4; ++ks) wfrag[ks] = *(const f16x8*)(ws16 + ((size_t)((hh) * 128 + pl)) * 128 + 32 * ks + 8 * g4); \
            gpre0 = *(const f32x4*)(lnvg + (hh) * 128 + 8 * ch); gpre1 = *(const f32x4*)(lnvg + (hh) * 128 + 8 * ch + 4); } while (0)
        MIX_PREFETCH(0);
        __syncthreads();
#pragma unroll 1
        for (int h = 0; h < 8; ++h) {
            LAS unsigned char* T = lds + (h & 1) * MX_TB;
            { const f32x4 g0 = gpre0, g1 = gpre1;
#pragma unroll
              for (int i = 0; i < 4; ++i) { const int q = qs + 32 * i; const float mean = STAT[2 * q], rstd = STAT[2 * q + 1]; const f16x8 x = vreg[i];
                u32x4 w; w.x = pk_f16(((float)x[0] - mean) * rstd * g0[0], ((float)x[1] - mean) * rstd * g0[1]); w.y = pk_f16(((float)x[2] - mean) * rstd * g0[2], ((float)x[3] - mean) * rstd * g0[3]);
                w.z = pk_f16(((float)x[4] - mean) * rstd * g1[0], ((float)x[5] - mean) * rstd * g1[1]); w.w = pk_f16(((float)x[6] - mean) * rstd * g1[2], ((float)x[7] - mean) * rstd * g1[3]);
                *(LAS u32x4*)(T + q * MX_LD + ch * 16) = w; } }
            u32x2 ucur[8]; f16x8 wcur[4];
#pragma unroll
            for (int ct = 0; ct < 8; ++ct) ucur[ct] = ureg[ct];
#pragma unroll
            for (int ks = 0; ks < 4; ++ks) wcur[ks] = wfrag[ks];
            const float bsv = bs[h * 128 + pl];
            { const int hn = (h + 1 < 8) ? h + 1 : 7; MIX_PREFETCH(hn); }
            __syncthreads();
            LAS unsigned char* tb = T + (8 * g4 + ((lane & 15) >> 2)) * MX_LD + (4 * (lane & 3)) * 2;
#pragma unroll
            for (int ct = 0; ct < 8; ++ct) {
                f32x4 acc = {0.f, 0.f, 0.f, 0.f};
#pragma unroll
                for (int ks = 0; ks < 4; ++ks) {
                    const f16x4 v1 = tr_read(tb + (32 * ks) * MX_LD + ct * 32), v2 = tr_read(tb + (32 * ks + 4) * MX_LD + ct * 32);
                    const f16x8 vf = {v1[0], v1[1], v1[2], v1[3], v2[0], v2[1], v2[2], v2[3]};
                    acc = __builtin_amdgcn_mfma_f32_16x16x32_f16(vf, wcur[ks], acc, 0, 0, 0);
                }
                const u32x2 uu = ucur[ct];
                u32x2 o; o.x = pk_f16(f16lo(uu.x) * (acc[0] + bsv), f16hi(uu.x) * (acc[1] + bsv)); o.y = pk_f16(f16lo(uu.y) * (acc[2] + bsv), f16hi(uu.y) * (acc[3] + bsv));
                *(u32x2*)(U16 + (r0 + pl) * D + h * 128 + 16 * ct + 4 * g4) = o;
            }
        }
#undef MIX_PREFETCH
        __syncthreads();
    }
}

constexpr int CW_BAR = 65536;
constexpr int LDSCTL_OFF = 131072 + 8192;
#define XB_TMO      128
#define XB_XCNT(j)  (256  + 64 * (j))
#define XB_XSUB(j)  (1280 + 64 * (j))
#define XB_XGEN(j)  (2304 + 64 * (j))
#define XB_TOP      3328
#define XB_TOPGEN   3392
#define XCD_BAR_WORDS 3456
#define XB_SPIN_CAP (1u << 18)

__device__ __forceinline__ unsigned xb_ld(unsigned* p)              { return __hip_atomic_load(p, __ATOMIC_RELAXED, __HIP_MEMORY_SCOPE_AGENT); }
__device__ __forceinline__ unsigned xb_add(unsigned* p, unsigned v) { return __hip_atomic_fetch_add(p, v, __ATOMIC_RELAXED, __HIP_MEMORY_SCOPE_AGENT); }
__device__ __forceinline__ unsigned xb_xcc_id() { return (unsigned)__builtin_amdgcn_s_getreg((3 << 11) | 20) & 0xFu; }
#define XB_SPIN(cond, bar) do { unsigned _sp = 0; while (cond) { __builtin_amdgcn_s_sleep(1); \
    if ((++_sp & 255u) == 0u) { if (xb_ld(&(bar)[XB_TMO])) break; if (_sp > XB_SPIN_CAP) { atomicAdd(&(bar)[XB_TMO], 1u); break; } } } } while (0)

struct XcdBarrier {
    unsigned* bar; unsigned x;
    volatile LAS unsigned* st;
};

__device__ __forceinline__ XcdBarrier xcd_barrier_post(unsigned* bar, volatile LAS unsigned* st) {
    XcdBarrier b; b.bar = bar; b.x = xb_xcc_id(); b.st = st;
    if (threadIdx.x == 0) (void)xb_add(&bar[XB_XCNT(b.x)], 1u);
    return b;
}
__device__ __forceinline__ void xcd_barrier_complete(unsigned* bar, unsigned x, unsigned& nloc, unsigned& nx) {
    const unsigned G = gridDim.x * gridDim.y * gridDim.z;
    unsigned sum, cnt, mine, sp = 0u;
    for (;;) {
        sum = 0u; cnt = 0u; mine = 0u;
#pragma unroll
        for (unsigned j = 0; j < 16; ++j) { const unsigned c = xb_ld(&bar[XB_XCNT(j)]); sum += c; cnt += (c > 0u) ? 1u : 0u; mine = (j == x) ? c : mine; }
        if (sum == G) break;
        __builtin_amdgcn_s_sleep(1);
        if ((++sp & 255u) == 0u) { if (xb_ld(&bar[XB_TMO])) break; if (sp > XB_SPIN_CAP) { atomicAdd(&bar[XB_TMO], 1u); break; } }
    }
    nloc = mine > 0u ? mine : 1u; nx = cnt > 0u ? cnt : 1u;
}

__device__ __forceinline__ void xcd_barrier(const XcdBarrier& b) {
    asm volatile("s_waitcnt vmcnt(0)" ::: "memory");
    __syncthreads();
    if (threadIdx.x == 0) {
        unsigned* bar = b.bar;
        __builtin_amdgcn_s_waitcnt(0);
        unsigned nloc = b.st[0], nx = b.st[1];
        if (nloc == 0u) { xcd_barrier_complete(bar, b.x, nloc, nx); b.st[0] = nloc; b.st[1] = nx; }
        const unsigned old = xb_add(&bar[XB_XSUB(b.x)], 1u);
        const unsigned gen = old / nloc;
        if (old + 1u == (gen + 1u) * nloc) {
            __builtin_amdgcn_fence(__ATOMIC_RELEASE, "agent");
            asm volatile("s_waitcnt vmcnt(0)" ::: "memory");
            const unsigned og = xb_add(&bar[XB_TOP], 1u);
            const unsigned tg = og / nx;
            if (og + 1u == (tg + 1u) * nx) xb_add(&bar[XB_TOPGEN], 1u);
            else XB_SPIN(xb_ld(&bar[XB_TOPGEN]) == tg, bar);
            __builtin_amdgcn_fence(__ATOMIC_ACQUIRE, "agent");
            xb_add(&bar[XB_XGEN(b.x)], 1u);
            asm volatile("s_waitcnt vmcnt(0)" ::: "memory");
        } else {
            XB_SPIN(xb_ld(&bar[XB_XGEN(b.x)]) == gen, bar);
            __builtin_amdgcn_fence(__ATOMIC_ACQUIRE, "agent");
            asm volatile("s_waitcnt vmcnt(0)" ::: "memory");
        }
    }
    __syncthreads();
}

#ifndef REP_P0
#define REP_P0 1
#endif
#ifndef REP_NORM
#define REP_NORM 1
#endif
#ifndef REP_SCAN
#define REP_SCAN 1
#endif
#ifndef REP_G1
#define REP_G1 1
#endif
#ifndef REP_G4
#define REP_G4 1
#endif
#ifndef REP_G7
#define REP_G7 1
#endif
#ifndef REP_G11
#define REP_G11 1
#endif
constexpr int PH_PER_LAYER = 14, NPHASES = 1 + NLAYER * PH_PER_LAYER + 1;
template <int ph> __device__ __forceinline__ void run_phase(const Args& a, LAS unsigned char* lds) {
    int tid = threadIdx.x; asm volatile("" : "+v"(tid));
    int bx = blockIdx.x; asm volatile("" : "+s"(bx));
    int G = gridDim.x; asm volatile("" : "+s"(G));
    int z = 0; asm volatile("" : "+s"(z));
    const int lane = tid & 63, wave = __builtin_amdgcn_readfirstlane(tid >> 6);
    const int gw = bx * NWAVES + wave, ngw = G * NWAVES;
    unsigned char* ws = a.ws;
    f16* W16 = (f16*)(ws + WS_W16);
    f16* RB = (f16*)(ws + WS_B);
    f16* BIG = (f16*)(ws + WS_BIG);
    f16* HB2 = BIG;
    f16* U16 = (f16*)(ws + WS_BIG + 48 * MiB);
    f16* G16 = (f16*)(ws + WS_BIG + 96 * MiB);
    float* X = a.out;
    const float* MOD = (const float*)(ws + WS_MOD);
    if (ph == 0) { for (int rep = 0; rep < REP_P0; ++rep) { p0_prologue(a, z, lds, G, bx, tid, wave, lane); __syncthreads(); } }
    else if (ph == NPHASES - 1) { final_norm_phase(X, a.in[z + I_FING], gw, ngw, lane); }
    else {
        constexpr int l = (ph - 1) / PH_PER_LAYER, k = (ph - 1) % PH_PER_LAYER;
        const float* modl = MOD + (size_t)l * 5 * 6144;
        float* xbuf = (float*)(ws + WS_BON + (size_t)M * 16 * 4); unsigned* ncnt = (unsigned*)(ws + WS_CTL) + 131072 + (size_t)(l * 2) * 96 * 64;
        constexpr bool x_in_out = (l > 0);
        const float* bc = x_in_out ? (const float*)X : a.in[z + I_XP];
        const float* bl = x_in_out ? (const float*)(X + (size_t)MCTX * D) : a.in[z + I_XS];
        if constexpr (k == 0) {
            if (l > 0) convert_layer_weights(a, z, l, lds, gw, ngw, wave, lane, bx * NTHR + tid, G * NTHR);
            if (l == 0 || G != 256) norm_phase(bc, bl, a.in[z + I_N1G] + l * D, modl, 0, 1, RB, gw, ngw, lane);
        } else if constexpr (k == 1) { pg8::Gemm g{RB, W16 + W_INR, M, ZRN, D}; pg8::EpiH16<0> E{BIG, ZRN, 0, 0};
            if (G == 256) { pg8::SeamOrder S; S.init(0, bx, nullptr); pg8::gemm_phase<pg8::EpiH16<0>, pg8::SeamOrder, true, true>(lds, g, S, E); }
            else { pg8::StaticOrder S; S.init(M, ZRN, G, bx); pg8::gemm_phase<pg8::EpiH16<0>, pg8::StaticOrder, true, true>(lds, g, S, E); }
        } else if constexpr (k == 2) {
            if (G == 256) {
                unsigned* c1 = (unsigned*)(ws + WS_CTL) + 49152 + l * 256; unsigned* c2 = c1 + 192;
                if (bx >= 128) {
                    pg8::Gemm g{RB, W16 + W_INR, M, ZRN, D}; pg8::EpiH16<0> E{BIG, ZRN, 0, 0}; pg8::SeamOrder S; S.init(1, bx - 128, c1);
                    pg8::gemm_phase<pg8::EpiH16<0>, pg8::SeamOrder, true, true>(lds, g, S, E);
                    asm volatile("s_waitcnt vmcnt(0)" ::: "memory"); __syncthreads();
                    if (tid == 0) { __builtin_amdgcn_fence(__ATOMIC_RELEASE, "agent"); asm volatile("s_waitcnt vmcnt(0)" ::: "memory"); (void)__hip_atomic_fetch_add(c2, 1u, __ATOMIC_RELAXED, __HIP_MEMORY_SCOPE_AGENT);
                        unsigned spins = 0; while (__hip_atomic_load(c2, __ATOMIC_RELAXED, __HIP_MEMORY_SCOPE_AGENT) < 128u) { __builtin_amdgcn_s_sleep(2); if (++spins > (1u << 24)) break; }
                        __builtin_amdgcn_fence(__ATOMIC_ACQUIRE, "agent"); asm volatile("s_waitcnt vmcnt(0)" ::: "memory"); }
                    __syncthreads();
                }
                scan_phase(a, z, l, lds, G, bx, tid, wave, lane, c1); __syncthreads();
            } else { scan_phase(a, z, l, lds, G, bx, tid, wave, lane); __syncthreads(); }
        } else if constexpr (k == 3) { if constexpr (l > 0) norm_phase(bc, bl, a.in[z + I_N1G] + l * D, modl, 0, 1, HB2, gw, ngw, lane);
        } else if constexpr (k == 4) { pg8::Gemm g{l == 0 ? RB : HB2, W16 + W_INUV, M, 2048, D}; pg8::StaticOrder S; S.init(M, 2048, G, bx); pg8::EpiH16<1> E{U16, D, 1024, (size_t)(48 * MiB / 2)};
            for (int rep = 0; rep < REP_G4; ++rep) pg8::gemm_phase<pg8::EpiH16<1>, pg8::StaticOrder, true, true>(lds, g, S, E);
        } else if constexpr (k == 5) { mix_phase(a, z, l, lds, G, bx, tid, wave, lane);
        } else if constexpr (k == 6) { pg8::Gemm g{l == 0 ? RB : HB2, W16 + W_ING, M, 2048, D}; pg8::StaticOrder S; S.init(M, 2048, G, bx); pg8::EpiH16<2> E{G16, 2048, 0, 0};
            pg8::gemm_phase<pg8::EpiH16<2>, pg8::StaticOrder, true, true>(lds, g, S, E);
        } else if constexpr (k == 7) { pg8::Gemm g7{l == 0 ? (const f16*)X : (const f16*)RB, W16 + W_A, M, D, D}; pg8::EpiMix<false> E7{HB2, G16, 0}; pg8::Gemm g8{U16, W16 + W_B, M, D, D}; pg8::EpiMix<true> E8{HB2, G16, 1024};
            if (G == 256) {
                if (bx < 128) { pg8::SubOrder S; S.init2(MCTX, D, 128, bx, 0, 0); pg8::gemm_phase<pg8::EpiMix<false>, pg8::SubOrder, true, true>(lds, g7, S, E7); pg8::gemm_phase<pg8::EpiMix<true>, pg8::SubOrder, true, true>(lds, g8, S, E8); }
                else { pg8::SubOrder S; S.init2(MLAT, D, 128, bx - 128, 32, 0); pg8::gemm_phase<pg8::EpiMix<false>, pg8::SubOrder, true, true>(lds, g7, S, E7); }
            } else { pg8::StaticOrder S; S.init(M, D, G, bx); pg8::gemm_phase<pg8::EpiMix<false>, pg8::StaticOrder, true, true>(lds, g7, S, E7); }
        } else if constexpr (k == 8) { pg8::Gemm g8{U16, W16 + W_B, M, D, D}; pg8::EpiMix<true> E8{HB2, G16, 1024};
            if (G == 256) {
                { pg8::SubOrder S; S.init2(MLAT, D, 256, bx, 32, 0); pg8::gemm_phase<pg8::EpiMix<true>, pg8::SubOrder, true, true>(lds, g8, S, E8); }
                if (bx < 128) { pg8::Gemm g9{HB2, W16 + W_OUT, M, D, D}; pg8::EpiResNorm<false> E9{bc, bl, X, modl + 2 * 1024, RB, a.in[z + I_N2G] + l * D, modl, 3, 4, xbuf, ncnt, EPS}; pg8::SubOrder S; S.init2(MCTX, D, 128, bx, 0, 0);
                    pg8::gemm_phase<pg8::EpiResNorm<false>, pg8::SubOrder, true, true>(lds, g9, S, E9); }
            } else { pg8::StaticOrder S; S.init(M, D, G, bx); pg8::gemm_phase<pg8::EpiMix<true>, pg8::StaticOrder, true, true>(lds, g8, S, E8); }
        } else if constexpr (k == 9) { pg8::Gemm g{HB2, W16 + W_OUT, M, D, D}; pg8::EpiRes E{bc, bl, X, modl + 2 * 1024};
            if (G == 256) { pg8::EpiResNorm<false> EN{bc, bl, X, modl + 2 * 1024, RB, a.in[z + I_N2G] + l * D, modl, 3, 4, xbuf, ncnt, EPS}; pg8::SubOrder S; S.init2(MLAT, D, 256, bx, 32, 0);
                pg8::gemm_phase<pg8::EpiResNorm<false>, pg8::SubOrder, true, true>(lds, g, S, EN); }
            else { pg8::StaticOrder S; S.init(M, D, G, bx); pg8::gemm_phase<pg8::EpiRes, pg8::StaticOrder, true, true>(lds, g, S, E); }
        } else if constexpr (k == 10) { norm_phase(X, X + (size_t)MCTX * D, a.in[z + I_N2G] + l * D, modl, 3, 4, RB, gw, ngw, lane);
        } else if constexpr (k == 11) { pg8::Gemm g{RB, W16 + W_1, M, DFF, D}; pg8::EpiH16<3> E{BIG, DFF, 0, 0};
            if (G == 256) { pg8::EpiH16B<3> EB{BIG, DFF}; pg8::SubOrder S; S.init2(MCTX, DFF, 256, bx, 0, 0); pg8::gemm_phase<pg8::EpiH16B<3>, pg8::SubOrder, true, true>(lds, g, S, EB); }
            else { pg8::StaticOrder S; S.init(M, DFF, G, bx); pg8::gemm_phase<pg8::EpiH16<3>, pg8::StaticOrder, true, true>(lds, g, S, E); }
        } else if constexpr (k == 12) {
            if (G == 256) {
                { pg8::Gemm g{RB, W16 + W_1, M, DFF, D}; pg8::EpiH16B<3> E{BIG, DFF}; pg8::SubOrder S; S.init2(MLAT, DFF, 256, bx, 32, bx < 128 ? 1 : 2); pg8::gemm_phase<pg8::EpiH16B<3>, pg8::SubOrder, true, true>(lds, g, S, E); }
                if (bx >= 128) { __syncthreads(); pg8::Gemm g{BIG, W16 + W_2, M, D, DFF}; pg8::SubOrder S; S.init2(MCTX, D, 128, bx - 128, 0, 0);
                    if constexpr (l + 1 < NLAYER) { pg8::EpiResNorm<false> E{X, X + (size_t)MCTX * D, X, modl + 5 * 1024, RB, a.in[z + I_N1G] + (l + 1) * D, MOD + (size_t)(l + 1) * 5 * 6144, 0, 1, xbuf, ncnt + 96 * 64, EPS};
                        pg8::gemm_phase<pg8::EpiResNorm<false>, pg8::SubOrder, true, true, true>(lds, g, S, E); }
                    else { pg8::EpiResNorm<true> E{X, X + (size_t)MCTX * D, X, modl + 5 * 1024, nullptr, a.in[z + I_FING], nullptr, 0, 0, xbuf, ncnt + 96 * 64, EPS};
                        pg8::gemm_phase<pg8::EpiResNorm<true>, pg8::SubOrder, true, true, true>(lds, g, S, E); } }
            } else { pg8::Gemm g{BIG, W16 + W_2, M, D, DFF}; pg8::StaticOrder S; S.init(M, D, G, bx); pg8::EpiRes E{X, X + (size_t)MCTX * D, X, modl + 5 * 1024};
                pg8::gemm_phase<pg8::EpiRes, pg8::StaticOrder, true, true>(lds, g, S, E); }
        } else {
            if (G == 256) { pg8::Gemm g{BIG, W16 + W_2, M, D, DFF}; pg8::SubOrder S; S.init2(MLAT, D, 256, bx, 32, 0);
                if constexpr (l + 1 < NLAYER) { pg8::EpiResNorm<false> E{X, X + (size_t)MCTX * D, X, modl + 5 * 1024, RB, a.in[z + I_N1G] + (l + 1) * D, MOD + (size_t)(l + 1) * 5 * 6144, 0, 1, xbuf, ncnt + 96 * 64, EPS};
                    pg8::gemm_phase<pg8::EpiResNorm<false>, pg8::SubOrder, true, true, true>(lds, g, S, E); }
                else { pg8::EpiResNorm<true> E{X, X + (size_t)MCTX * D, X, modl + 5 * 1024, nullptr, a.in[z + I_FING], nullptr, 0, 0, xbuf, ncnt + 96 * 64, EPS};
                    pg8::gemm_phase<pg8::EpiResNorm<true>, pg8::SubOrder, true, true, true>(lds, g, S, E); } }
        }
    }
}
template <int ph> __device__ __forceinline__ void run_phases(const Args& a, LAS unsigned char* lds, cg::grid_group& grid, const XcdBarrier& bar) {
    if constexpr (ph < NPHASES) {
        constexpr bool empty_phase = (ph == 1 + 3);
        constexpr bool fused_norm_phase = (ph == NPHASES - 1) || (ph >= 1 && ph < NPHASES - 1 && (ph - 1) % PH_PER_LAYER == 10);
        const bool g256 = (gridDim.x == 256);
        if (!empty_phase && !(fused_norm_phase && g256) && a.ph_lo <= ph && ph < a.ph_hi) { run_phase<ph>(a, lds); if (ph + 1 < a.ph_hi && !(g256 && ph + 1 == NPHASES - 1)) { if (a.ph_lo > a.ph_hi) grid.sync(); else xcd_barrier(bar); } }
        run_phases<ph + 1>(a, lds, grid, bar);
    }
}
__global__ void __launch_bounds__(NTHR, 2) fwd_kernel(Args a) {
    extern __shared__ __attribute__((aligned(16))) unsigned char lds_raw[];
    LAS unsigned char* lds = (LAS unsigned char*)lds_raw;
    cg::grid_group grid = cg::this_grid();
    volatile LAS unsigned* bst = (volatile LAS unsigned*)(lds + LDSCTL_OFF);
    if (threadIdx.x < 2) bst[threadIdx.x] = 0u;
    __syncthreads();
    const XcdBarrier bar = xcd_barrier_post((unsigned*)(a.ws + WS_CTL) + CW_BAR, bst);
    run_phases<0>(a, lds, grid, bar);
}

extern "C" void kernel_launch(void* const* d_in, const int* in_sizes, int n_in, void* d_out, int out_size, void* d_ws, size_t ws_size, hipStream_t stream) {
    static int grid = 0;
    if (grid == 0) {
        if (n_in != N_IN || ws_size < WS_END) { fprintf(stderr, "kernel_launch: n_in %d (want %d), ws %zu (want >= %zu): nothing launched\n", n_in, (int)N_IN, ws_size, (size_t)WS_END); grid = -1; return; }
        int dev = 0, cus = 0, per_cu = 0;
        if (hipGetDevice(&dev) != hipSuccess || hipDeviceGetAttribute(&cus, hipDeviceAttributeMultiprocessorCount, dev) != hipSuccess) { grid = -1; return; }
        if (hipFuncSetAttribute((const void*)fwd_kernel, hipFuncAttributeMaxDynamicSharedMemorySize, LDS_BYTES) != hipSuccess) { fprintf(stderr, "kernel_launch: hipFuncSetAttribute failed\n"); grid = -1; return; }
        if (hipOccupancyMaxActiveBlocksPerMultiprocessor(&per_cu, (const void*)fwd_kernel, NTHR, LDS_BYTES) != hipSuccess || per_cu < 1) { fprintf(stderr, "kernel_launch: occupancy query says %d\n", per_cu); (void)hipGetLastError(); grid = -1; return; }
        grid = cus;
    }
    if (grid < 0) return;
    if (hipMemsetAsync((char*)d_ws + WS_CTL, 0, CTL_ZERO_BYTES, stream) != hipSuccess) { fprintf(stderr, "kernel_launch: memset failed\n"); return; }
    Args a{};
    for (int i = 0; i < N_IN; ++i) a.in[i] = (const float*)d_in[i];
    a.out = (float*)d_out; a.ws = (unsigned char*)d_ws;
#if MK_PER_PHASE
    for (int ph = 0; ph < NPHASES; ++ph) { a.ph_lo = ph; a.ph_hi = ph + 1; hipLaunchKernelGGL(fwd_kernel, dim3(grid), dim3(NTHR), LDS_BYTES, stream, a); }
#else
    a.ph_lo = 0; a.ph_hi = NPHASES;
    void* args[] = {&a};
    hipError_t e = hipLaunchCooperativeKernel((const void*)fwd_kernel, dim3(grid), dim3(NTHR), args, LDS_BYTES, stream);
    if (e != hipSuccess) fprintf(stderr, "kernel_launch: cooperative launch failed: %s (grid %d)\n", hipGetErrorString(e), grid);
#endif
}
```

```cpp
#include <hip/hip_runtime.h>
#include <hip/hip_cooperative_groups.h>
#include <cstdio>
#include <cstdint>
namespace cg = cooperative_groups;

#ifndef MK_PER_PHASE
#define MK_PER_PHASE 0
#endif

namespace pg8 {
#define PG8_LAS __attribute__((address_space(3)))
typedef _Float16 f16_t;
typedef _Float16 f16x8 __attribute__((ext_vector_type(8)));
typedef float f32x4 __attribute__((ext_vector_type(4)));
typedef unsigned u32x4 __attribute__((ext_vector_type(4)));
constexpr int BM = 256, BK = 64, HALF = 128, HTB = HALF * BK * 2  , STAGE_BYTES = 8 * HTB, NXCD = 8, WGM = 8;

__host__ __device__ __forceinline__ int lds_byte(int r, int c) { const int st = (r >> 4) * 2 + (c >> 5), rr = r & 15, cc = c & 31, ob = rr * 64 + cc * 2; return st * 1024 + (ob ^ (((ob >> 9) & 1) << 5)); }
__host__ __device__ __forceinline__ void stage_rc(int b, int& R, int& C) { const int st = b / 1024, sb = b % 1024, swz = sb ^ (((sb >> 9) & 1) << 5); R = (st >> 1) * 16 + swz / 64; C = (st & 1) * 32 + (swz % 64) / 2; }
__host__ __device__ __forceinline__ int perm32(int rho) { const int n = rho >> 4, i = rho & 15; return 8 * (i >> 2) + 4 * n + (i & 3); }

struct Unit { int pm, pn, tag; };
struct Gemm { const f16_t* A; const f16_t* Bt; int M, N, K; };

struct StaticOrder {
    int nM, nN, nwg, G, c;
    __host__ __device__ void init(int M, int N, int G_, int c_) { nM = M / BM; nN = N / BM; nwg = nM * nN; G = G_; c = c_; }
    __host__ __device__ bool next(int i, Unit& u) const { const long L = (long)i * G + c; if (L >= nwg) return false; decode(L, u); return true; }
    __host__ __device__ void decode(long L, Unit& u) const {
        int wgid = (int)L; { const int q = nwg / NXCD, r = nwg % NXCD, xcd = wgid % NXCD, off = wgid / NXCD; wgid = (xcd < r ? xcd * (q + 1) : r * (q + 1) + (xcd - r) * q) + off; }
        const int nig = WGM * nN, gid = wgid / nig, fm = gid * WGM, gsz = (nM - fm) < WGM ? (nM - fm) : WGM;
        u.pm = fm + ((wgid % nig) % gsz); u.pn = (wgid % nig) / gsz; u.tag = 0;
    }
    __device__ __forceinline__ void a_ready(const Unit&) const {}
    __device__ __forceinline__ void done(const Unit&) const {}
};

struct SubOrder : StaticOrder {
    int pm0, kind;
    __device__ void init2(int Mv, int N, int Gv, int c_, int pm0_, int kind_) { init(Mv, N, Gv, c_); pm0 = pm0_; kind = kind_; }
    __device__ bool next(int i, Unit& u) const {
        long L;
        if (kind == 0) L = (long)i * G + c;
        else if (kind == 1) { if (i >= 6) return false; L = i < 2 ? i * 256 + c : (2 + ((i - 2) >> 1)) * 256 + c + 128 * ((i - 2) & 1); }
        else { if (i >= 2) return false; L = i * 256 + c; }
        if (L >= nwg) return false;
        decode(L, u); u.pm += pm0; return true;
    }
};

struct SeamOrder {
    int mode, x, j, nj; unsigned* cnt;
    __device__ void init(int mode_, int c, unsigned* cnt_) { mode = mode_; x = c & 7; j = c >> 3; nj = mode_ == 0 ? 32 : 16; cnt = cnt_; }
    __device__ bool next(int i, Unit& u) const {
        const int s = i * nj + j;
        if (mode == 0) { if (s >= 28) return false; const int o = 2 * x + (s & 1), ii = o & 3; u.pm = 32 + 16 * (o >> 2) + (ii < 2 ? ii : 12 + ii); u.pn = s >> 1; u.tag = 0; return true; }
        if (s >= 140) return false;
        if (s < 28) { const int o = 2 * x + (s & 1), ii = o & 3; u.pm = 32 + 16 * (o >> 2) + (ii < 2 ? 2 + ii : 10 + ii); u.pn = s >> 1; u.tag = (s + nj >= 28) ? 1 : 0; }
        else if (s < 84) { const int s1 = s - 28, o = 4 * x + (s1 & 3); u.pm = 32 + 16 * (o >> 3) + 4 + (o & 7); u.pn = s1 >> 2; u.tag = (s + nj >= 84) ? 2 : 0; }
        else { const int s2 = s - 84; u.pm = 4 * x + (s2 & 3); u.pn = s2 >> 2; u.tag = 0; }
        return true;
    }
    __device__ __forceinline__ void a_ready(const Unit&) const {}
    __device__ __forceinline__ void done(const Unit& u) const {
        if (u.tag) { asm volatile("s_waitcnt vmcnt(0)" ::: "memory"); __builtin_amdgcn_s_barrier();
            if (threadIdx.x == 0) { __builtin_amdgcn_fence(__ATOMIC_RELEASE, "agent"); asm volatile("s_waitcnt vmcnt(0)" ::: "memory"); (void)__hip_atomic_fetch_add(cnt + (u.tag == 2 ? 64 : 0), 1u, __ATOMIC_RELAXED, __HIP_MEMORY_SCOPE_AGENT); } }
    }
};

typedef _Float16 f16x2 __attribute__((ext_vector_type(2)));
typedef float f32x2 __attribute__((ext_vector_type(2)));
__device__ __forceinline__ unsigned pk_f16(float lo, float hi) { f32x2 v = {lo, hi}; f16x2 h = __builtin_convertvector(v, f16x2); return __builtin_bit_cast(unsigned, h); }
__device__ __forceinline__ float f16lo(unsigned w) { f16x2 h = __builtin_bit_cast(f16x2, w); return (float)h.x; }
__device__ __forceinline__ float f16hi(unsigned w) { f16x2 h = __builtin_bit_cast(f16x2, w); return (float)h.y; }
__device__ __forceinline__ float fast_sigmoid(float x) { return __builtin_amdgcn_rcpf(1.0f + __expf(-x)); }
__device__ __forceinline__ float gelu_tanh(float x) { const float y = 1.5957691216057308f * (x + 0.044715f * x * x * x); return x * __builtin_amdgcn_rcpf(1.0f + __expf(-y)); }
template <int ACT> __device__ __forceinline__ float act_fn(float x) {
    if (ACT == 1) return gelu_tanh(x);
    if (ACT == 2) return fast_sigmoid(x);
    if (ACT == 3) { const float r = x > 0.f ? x : 0.f; return r * r; }
    return x;
}
template <int ACT> struct EpiH16 {
    static constexpr bool PERM = true, AFTER_DRAIN = false;
    f16_t* O; int ldc; int split_cols; size_t split_stride;
    __device__ __forceinline__ void operator()(const f32x4 (&acc)[2][2][4][2], const Unit& u, int wr, int wc, int fr, int fq) const {
        const int row0 = u.pm * BM + wr * 64 + fr; int colt = u.pn * BM; f16_t* base = O;
        if (split_cols) { const int t = colt / split_cols; base += (size_t)t * split_stride; colt -= t * split_cols; }
        const int col0 = colt + wc * 32 + 8 * fq;
#pragma unroll
        for (int ai = 0; ai < 2; ++ai)
#pragma unroll
            for (int m = 0; m < 4; ++m) { f16_t* rowp = base + (size_t)(row0 + ai * HALF + m * 16) * ldc + col0;
#pragma unroll
                for (int bj = 0; bj < 2; ++bj) { const f32x4 v0 = acc[ai][bj][m][0], v1 = acc[ai][bj][m][1];
                    u32x4 w; w.x = pk_f16(act_fn<ACT>(v0[0]), act_fn<ACT>(v0[1])); w.y = pk_f16(act_fn<ACT>(v0[2]), act_fn<ACT>(v0[3]));
                    w.z = pk_f16(act_fn<ACT>(v1[0]), act_fn<ACT>(v1[1])); w.w = pk_f16(act_fn<ACT>(v1[2]), act_fn<ACT>(v1[3]));
                    *(u32x4*)(rowp + bj * HALF) = w; } }
    }
};
template <int ACT> struct EpiH16B {
    static constexpr bool PERM = true, AFTER_DRAIN = false;
    f16_t* O; int ldc;
    __device__ __forceinline__ void operator()(const f32x4 (&acc)[2][2][4][2], const Unit& u, int wr, int wc, int fr, int fq) const {
        f16_t* base = O + (size_t)u.pm * BM * ldc + (size_t)(wr * 64 + fr) * BK;
#pragma unroll
        for (int bj = 0; bj < 2; ++bj) { const int c = u.pn * BM + bj * HALF + wc * 32 + 8 * fq; f16_t* cp = base + (size_t)(c >> 6) * (BM * BK) + (c & 63);
#pragma unroll
            for (int ai = 0; ai < 2; ++ai)
#pragma unroll
                for (int m = 0; m < 4; ++m) { const f32x4 v0 = acc[ai][bj][m][0], v1 = acc[ai][bj][m][1];
                    u32x4 w; w.x = pk_f16(act_fn<ACT>(v0[0]), act_fn<ACT>(v0[1])); w.y = pk_f16(act_fn<ACT>(v0[2]), act_fn<ACT>(v0[3]));
                    w.z = pk_f16(act_fn<ACT>(v1[0]), act_fn<ACT>(v1[1])); w.w = pk_f16(act_fn<ACT>(v1[2]), act_fn<ACT>(v1[3]));
                    *(u32x4*)(cp + (ai * HALF + m * 16) * BK) = w; } }
    }
};
template <bool ADD> struct EpiMix {
    static constexpr bool PERM = true, AFTER_DRAIN = false;
    f16_t* MIX; const f16_t* G; int gcol;
    __device__ __forceinline__ void operator()(const f32x4 (&acc)[2][2][4][2], const Unit& u, int wr, int wc, int fr, int fq) const {
        const int row0 = u.pm * BM + wr * 64 + fr; const int col0 = u.pn * BM + wc * 32 + 8 * fq;
#pragma unroll
        for (int ai = 0; ai < 2; ++ai)
#pragma unroll
            for (int m = 0; m < 4; ++m) { const size_t row = (size_t)(row0 + ai * HALF + m * 16);
#pragma unroll
                for (int bj = 0; bj < 2; ++bj) { const f32x4 v0 = acc[ai][bj][m][0], v1 = acc[ai][bj][m][1];
                    const u32x4 g = *(const u32x4*)(G + row * 2048 + gcol + col0 + bj * HALF);
                    float o[8] = {v0[0] * f16lo(g.x), v0[1] * f16hi(g.x), v0[2] * f16lo(g.y), v0[3] * f16hi(g.y), v1[0] * f16lo(g.z), v1[1] * f16hi(g.z), v1[2] * f16lo(g.w), v1[3] * f16hi(g.w)};
                    f16_t* p = MIX + row * 1024 + col0 + bj * HALF;
                    if (ADD) { const u32x4 q = *(const u32x4*)p; o[0] += f16lo(q.x); o[1] += f16hi(q.x); o[2] += f16lo(q.y); o[3] += f16hi(q.y); o[4] += f16lo(q.z); o[5] += f16hi(q.z); o[6] += f16lo(q.w); o[7] += f16hi(q.w); }
                    u32x4 w; w.x = pk_f16(o[0], o[1]); w.y = pk_f16(o[2], o[3]); w.z = pk_f16(o[4], o[5]); w.w = pk_f16(o[6], o[7]);
                    *(u32x4*)p = w; } }
    }
};
struct EpiRes {
    static constexpr bool PERM = false, AFTER_DRAIN = false;
    const float* base_ctx; const float* base_lat; float* X; const float* gate;
    __device__ __forceinline__ void operator()(const f32x4 (&acc)[2][2][4][2], const Unit& u, int wr, int wc, int fr, int fq) const {
        const int row0 = u.pm * BM + wr * 64 + fr, col0 = u.pn * BM + wc * 32 + 4 * fq;
        const int s = u.pm < 32 ? 0 : 1 + ((u.pm - 32) >> 4);
        const float* gp = gate + s * 6144 + col0;
        f32x4 gv[2][2];
#pragma unroll
        for (int bj = 0; bj < 2; ++bj)
#pragma unroll
            for (int n = 0; n < 2; ++n) gv[bj][n] = *(const f32x4*)(gp + bj * HALF + n * 16);
#pragma unroll
        for (int ai = 0; ai < 2; ++ai)
#pragma unroll
            for (int m = 0; m < 4; ++m) { const int row = row0 + ai * HALF + m * 16;
                const float* bp = (row < 8192 ? base_ctx + (size_t)row * 1024 : base_lat + (size_t)(row - 8192) * 1024) + col0;
                float* xp = X + (size_t)row * 1024 + col0;
#pragma unroll
                for (int bj = 0; bj < 2; ++bj)
#pragma unroll
                    for (int n = 0; n < 2; ++n) { const f32x4 b = *(const f32x4*)(bp + bj * HALF + n * 16); *(f32x4*)(xp + bj * HALF + n * 16) = b + gv[bj][n] * acc[ai][bj][m][n]; } }
    }
};
template <bool FINAL> struct EpiResNorm {
    static constexpr bool PERM = false, AFTER_DRAIN = true;
    const float* base_ctx; const float* base_lat; float* X; const float* gate;
    f16_t* H; const float* gain; const float* modn; int sh_idx, sc_idx;
    float* xbuf; unsigned* cnt; float eps;
    __device__ __forceinline__ void fused(f32x4 (&acc)[2][2][4][2], const Unit& u, int wr, int wc, int fr, int fq, PG8_LAS unsigned char* lds, int wid, int lane) const {
        PG8_LAS float* P = (PG8_LAS float*)lds; PG8_LAS float* S = (PG8_LAS float*)(lds + 8192);
        const int row0 = u.pm * BM + wr * 64 + fr, col0 = u.pn * BM + wc * 32 + 4 * fq;
        const int s = u.pm < 32 ? 0 : 1 + ((u.pm - 32) >> 4);
        {
            const float* gp = gate + s * 6144 + col0;
            f32x4 gv[2][2];
#pragma unroll
            for (int bj = 0; bj < 2; ++bj)
#pragma unroll
                for (int n = 0; n < 2; ++n) gv[bj][n] = *(const f32x4*)(gp + bj * HALF + n * 16);
#pragma unroll
            for (int ai = 0; ai < 2; ++ai)
#pragma unroll
                for (int m = 0; m < 4; ++m) { const int row = row0 + ai * HALF + m * 16;
                    const float* bp = (row < 8192 ? base_ctx + (size_t)row * 1024 : base_lat + (size_t)(row - 8192) * 1024) + col0;
                    float* xp = X + (size_t)row * 1024 + col0; float ss = 0.f;
#pragma unroll
                    for (int bj = 0; bj < 2; ++bj)
#pragma unroll
                        for (int n = 0; n < 2; ++n) { const f32x4 b = *(const f32x4*)(bp + bj * HALF + n * 16); const f32x4 x = b + gv[bj][n] * acc[ai][bj][m][n]; acc[ai][bj][m][n] = x;
                            if (!FINAL) *(f32x4*)(xp + bj * HALF + n * 16) = x;
                            ss += (x[0] * x[0] + x[1] * x[1]) + (x[2] * x[2] + x[3] * x[3]); }
                    ss += __shfl_xor(ss, 16); ss += __shfl_xor(ss, 32);
                    if (fq == 0) P[(ai * HALF + wr * 64 + m * 16 + fr) * 4 + wc] = ss;
                    asm volatile("" ::: "memory"); }
        }
        asm volatile("s_waitcnt lgkmcnt(0)" ::: "memory"); __builtin_amdgcn_s_barrier(); asm volatile("" ::: "memory");
        const int row = wid * 32 + (lane & 31);
        if (lane < 32) { const f32x4 p = *(const PG8_LAS f32x4*)(P + row * 4);
            __hip_atomic_store(xbuf + ((size_t)(u.pm * BM + row) * 4 + u.pn), (p[0] + p[1]) + (p[2] + p[3]), __ATOMIC_RELAXED, __HIP_MEMORY_SCOPE_AGENT); }
        asm volatile("s_waitcnt vmcnt(0)" ::: "memory");
        if (lane == 0) (void)__hip_atomic_fetch_add(cnt + 64 * u.pm, 1u, __ATOMIC_RELAXED, __HIP_MEMORY_SCOPE_AGENT);
        if (wid == 0) { unsigned spins = 0;
            while ((unsigned)__builtin_amdgcn_readfirstlane(__hip_atomic_load(cnt + 64 * u.pm, __ATOMIC_RELAXED, __HIP_MEMORY_SCOPE_AGENT)) < 32u) { __builtin_amdgcn_s_sleep(2); if (++spins > (1u << 22)) break; }
            __builtin_amdgcn_fence(__ATOMIC_ACQUIRE, "agent"); }
        asm volatile("s_waitcnt vmcnt(0) lgkmcnt(0)" ::: "memory"); __builtin_amdgcn_s_barrier(); asm volatile("" ::: "memory");
        if (lane < 32) { const float* sl = xbuf + (size_t)(u.pm * BM + row) * 4; float t = 0.f;
#pragma unroll
            for (int k = 0; k < 4; ++k) t += __hip_atomic_load(sl + k, __ATOMIC_RELAXED, __HIP_MEMORY_SCOPE_AGENT);
            S[row] = __builtin_amdgcn_rsqf(t * (1.0f / 1024.0f) + eps); }
        asm volatile("s_waitcnt lgkmcnt(0)" ::: "memory"); __builtin_amdgcn_s_barrier(); asm volatile("" ::: "memory");
#pragma unroll
        for (int bj = 0; bj < 2; ++bj)
#pragma unroll
            for (int n = 0; n < 2; ++n) { const int c = col0 + bj * HALF + n * 16;
                f32x4 gm = *(const f32x4*)(gain + c), sh = {0.f, 0.f, 0.f, 0.f};
                if (!FINAL) { gm = gm * (*(const f32x4*)(modn + (size_t)s * 6144 + sc_idx * 1024 + c) + 1.0f); sh = *(const f32x4*)(modn + (size_t)s * 6144 + sh_idx * 1024 + c); }
#pragma unroll
                for (int ai = 0; ai < 2; ++ai)
#pragma unroll
                    for (int m = 0; m < 4; ++m) { const int r = ai * HALF + wr * 64 + m * 16 + fr; const float rs = S[r]; const size_t off = (size_t)(u.pm * BM + r) * 1024 + c;
                        const f32x4 y = acc[ai][bj][m][n] * rs * gm + sh;
                        if (FINAL) *(f32x4*)(X + off) = y;
                        else { typedef unsigned u32x2p __attribute__((ext_vector_type(2))); u32x2p w; w.x = pk_f16(y[0], y[1]); w.y = pk_f16(y[2], y[3]); *(u32x2p*)(H + off) = w; } }
            }
    }
};

template <class Epi, class Sched, bool ALIGN_EPI = false, bool SP2 = false, bool ABLK = false>
__device__ __forceinline__ void gemm_phase(PG8_LAS unsigned char* lds, const Gemm g, const Sched& S, const Epi& E) {
    const int tid = threadIdx.x, wid = __builtin_amdgcn_readfirstlane(tid >> 6), lane = tid & 63, wr = wid >> 2, wc = wid & 3, fr = lane & 15, fq = lane >> 4;
    const int K = g.K, nt = K / BK;
    unsigned voffA[2], voffB[2];
#pragma unroll
    for (int i = 0; i < 2; ++i) { int R, C; stage_rc(tid * 16 + i * 8192, R, C); const int Rb = Epi::PERM ? ((R & ~31) + perm32(R & 31)) : R;
        voffA[i] = (unsigned)(R * (ABLK ? BK : K) + C) * 2u; voffB[i] = (unsigned)(Rb * K + C) * 2u; }
    const size_t kstep = (size_t)(BK * 2);
    const size_t hstep = (size_t)HALF * K * 2;
    const size_t tstep = 2 * hstep;
    const size_t kstepA = ABLK ? (size_t)BM * BK * 2 : kstep, hstepA = ABLK ? (size_t)HALF * BK * 2 : hstep;
    const unsigned ldsw = (unsigned)wid * 1024u;
    const int aoff = lds_byte(wr * 64 + fr, fq * 8), boff = lds_byte(wc * 32 + fr, fq * 8);
#define PG8_SA(b, h) (((b) * 2 + (h)) * HTB)
#define PG8_SB(b, h) ((4 + (b) * 2 + (h)) * HTB)
#define PG8_STAGE(bufoff, gbase, voff) do { _Pragma("unroll") for (int _i = 0; _i < 2; ++_i) \
        __builtin_amdgcn_global_load_lds((const unsigned*)((const char*)(gbase) + (voff)[_i]), (PG8_LAS unsigned*)(lds + (bufoff) + ldsw + _i * 8192), 16, 0, 0); } while (0)
#define PG8_LDA(dst, b, h) do { _Pragma("unroll") for (int m = 0; m < 4; ++m) _Pragma("unroll") for (int k = 0; k < 2; ++k) dst[m][k] = *(const PG8_LAS f16x8*)(lds + PG8_SA(b, h) + aoff + m * 2048 + k * 1024); } while (0)
#define PG8_LDB(dst, b, h) do { _Pragma("unroll") for (int n = 0; n < 2; ++n) _Pragma("unroll") for (int k = 0; k < 2; ++k) dst[n][k] = *(const PG8_LAS f16x8*)(lds + PG8_SB(b, h) + boff + n * 2048 + k * 1024); } while (0)
#define PG8_MMA(ai, bj, At, Bt) do { __builtin_amdgcn_s_setprio(1); _Pragma("unroll") for (int m = 0; m < 4; ++m) _Pragma("unroll") for (int n = 0; n < 2; ++n) _Pragma("unroll") for (int k = 0; k < 2; ++k) \
        acc[ai][bj][m][n] = __builtin_amdgcn_mfma_f32_16x16x32_f16(Bt[n][k], At[m][k], acc[ai][bj][m][n], 0, 0, 0); __builtin_amdgcn_s_setprio(0); } while (0)
#define PG8_WAIT_V(n) asm volatile("s_waitcnt vmcnt(" #n ")" ::: "memory")
#define PG8_WAIT_L(n) asm volatile("s_waitcnt lgkmcnt(" #n ")" ::: "memory")
#define PG8_BAR __builtin_amdgcn_s_barrier()
#define PG8_SCHED __builtin_amdgcn_sched_barrier(0)
    Unit cur, nxt; int ui = 0;
    if (!S.next(0, cur)) return;
    f32x4 acc[2][2][4][2];
#pragma unroll
    for (int a = 0; a < 2; ++a)
#pragma unroll
        for (int b = 0; b < 2; ++b)
#pragma unroll
            for (int m = 0; m < 4; ++m)
#pragma unroll
                for (int n = 0; n < 2; ++n) acc[a][b][m][n] = (f32x4){0.f, 0.f, 0.f, 0.f};
    f16x8 At[4][2], B0[2][2], B1[2][2];
    const char* cA = (const char*)g.A + (size_t)cur.pm * tstep; const char* cB = (const char*)g.Bt + (size_t)cur.pn * tstep;
    S.a_ready(cur);
    if constexpr (SP2) {
        PG8_STAGE(PG8_SB(0, 0), cB, voffB); PG8_STAGE(PG8_SB(0, 1), cB + hstep, voffB); PG8_STAGE(PG8_SA(0, 0), cA, voffA); PG8_STAGE(PG8_SA(0, 1), cA + hstepA, voffA);
        if (wr == 1) PG8_BAR;
        PG8_WAIT_V(2); PG8_BAR;
        PG8_STAGE(PG8_SB(1, 0), cB + kstep, voffB); PG8_STAGE(PG8_SA(1, 0), cA + kstepA, voffA); PG8_STAGE(PG8_SB(1, 1), cB + hstep + kstep, voffB);
        PG8_WAIT_V(6); PG8_BAR;
    } else {
        PG8_STAGE(PG8_SB(0, 0), cB, voffB); PG8_STAGE(PG8_SA(0, 0), cA, voffA); PG8_STAGE(PG8_SB(0, 1), cB + hstep, voffB); PG8_STAGE(PG8_SA(0, 1), cA + hstepA, voffA);
        if (wr == 1) PG8_BAR;
        PG8_WAIT_V(4); PG8_BAR;
        PG8_STAGE(PG8_SB(1, 0), cB + kstep, voffB); PG8_STAGE(PG8_SA(1, 0), cA + kstepA, voffA); PG8_STAGE(PG8_SB(1, 1), cB + hstep + kstep, voffB);
        PG8_WAIT_V(6); PG8_BAR;
    }
    for (;;) {
        const bool has_next = S.next(ui + 1, nxt);
        const char* nA = has_next ? (const char*)g.A + (size_t)nxt.pm * tstep : cA; const char* nB = has_next ? (const char*)g.Bt + (size_t)nxt.pn * tstep : cB;
        for (int t = 0; t < nt; t += 2) {
            const bool last = (t == nt - 2);
            const char* a1 = cA + (size_t)(t + 1) * kstepA;
            const char* a2 = last ? nA : cA + (size_t)(t + 2) * kstepA; const char* b2 = last ? nB : cB + (size_t)(t + 2) * kstep;
            const char* a3 = a2 + kstepA; const char* b3 = b2 + kstep;
            if (last && has_next) S.a_ready(nxt);
            if constexpr (SP2) {
            PG8_LDB(B0, 0, 0); PG8_LDB(B1, 0, 1); PG8_SCHED; PG8_LDA(At, 0, 0); PG8_STAGE(PG8_SA(1, 1), a1 + hstepA, voffA);
            PG8_WAIT_V(8); PG8_WAIT_L(0); PG8_BAR; PG8_MMA(0, 0, At, B0); PG8_MMA(0, 1, At, B1); PG8_BAR; PG8_SCHED;
            PG8_LDA(At, 0, 1); PG8_STAGE(PG8_SB(0, 0), b2, voffB); PG8_STAGE(PG8_SB(0, 1), b2 + hstep, voffB); PG8_STAGE(PG8_SA(0, 0), a2, voffA);
            PG8_WAIT_V(8); PG8_WAIT_L(0); PG8_BAR; PG8_MMA(1, 0, At, B0); PG8_MMA(1, 1, At, B1); PG8_BAR; PG8_SCHED;
            PG8_LDB(B0, 1, 0); PG8_LDB(B1, 1, 1); PG8_SCHED; PG8_LDA(At, 1, 0); PG8_STAGE(PG8_SA(0, 1), a2 + hstepA, voffA);
            PG8_WAIT_V(8); PG8_WAIT_L(0); PG8_BAR; PG8_MMA(0, 0, At, B0); PG8_MMA(0, 1, At, B1); PG8_BAR; PG8_SCHED;
            PG8_LDA(At, 1, 1); PG8_STAGE(PG8_SB(1, 0), b3, voffB); PG8_STAGE(PG8_SB(1, 1), b3 + hstep, voffB); PG8_STAGE(PG8_SA(1, 0), a3, voffA);
            PG8_WAIT_V(8); PG8_WAIT_L(0); PG8_BAR; PG8_MMA(1, 0, At, B0); PG8_MMA(1, 1, At, B1); PG8_BAR; PG8_SCHED;
            } else {
            PG8_LDB(B0, 0, 0); PG8_SCHED; PG8_LDA(At, 0, 0); PG8_STAGE(PG8_SA(1, 1), a1 + hstepA, voffA);
            PG8_WAIT_L(8); PG8_BAR; PG8_WAIT_L(0); PG8_MMA(0, 0, At, B0); PG8_BAR; PG8_SCHED;
            PG8_LDB(B1, 0, 1); PG8_STAGE(PG8_SB(0, 0), b2, voffB);
            PG8_BAR; PG8_WAIT_L(0); PG8_MMA(0, 1, At, B1); PG8_BAR;
            PG8_LDA(At, 0, 1); PG8_STAGE(PG8_SA(0, 0), a2, voffA);
            PG8_BAR; PG8_WAIT_L(0); PG8_MMA(1, 0, At, B0); PG8_BAR; PG8_SCHED;
            PG8_STAGE(PG8_SB(0, 1), b2 + hstep, voffB);
            PG8_WAIT_V(6); PG8_BAR; PG8_MMA(1, 1, At, B1); PG8_BAR;
            PG8_LDB(B0, 1, 0); PG8_SCHED; PG8_LDA(At, 1, 0); PG8_STAGE(PG8_SA(0, 1), a2 + hstepA, voffA);
            PG8_WAIT_L(8); PG8_BAR; PG8_WAIT_L(0); PG8_MMA(0, 0, At, B0); PG8_BAR; PG8_SCHED;
            PG8_LDB(B1, 1, 1); PG8_STAGE(PG8_SB(1, 0), b3, voffB);
            PG8_BAR; PG8_WAIT_L(0); PG8_MMA(0, 1, At, B1); PG8_BAR;
            PG8_LDA(At, 1, 1); PG8_STAGE(PG8_SA(1, 0), a3, voffA);
            PG8_BAR; PG8_WAIT_L(0); PG8_MMA(1, 0, At, B0); PG8_BAR; PG8_SCHED;
            PG8_STAGE(PG8_SB(1, 1), b3 + hstep, voffB);
            PG8_WAIT_V(6); PG8_BAR; PG8_MMA(1, 1, At, B1); PG8_BAR;
            }
        }
        if constexpr (ALIGN_EPI) { if (wr == 0) PG8_BAR; }
        if constexpr (!Epi::AFTER_DRAIN) { E(acc, cur, wr, wc, fr, fq); S.done(cur); }
        if (!has_next) break;
#pragma unroll
        for (int a = 0; a < 2; ++a)
#pragma unroll
            for (int b = 0; b < 2; ++b)
#pragma unroll
                for (int m = 0; m < 4; ++m)
#pragma unroll
                    for (int n = 0; n < 2; ++n) acc[a][b][m][n] = (f32x4){0.f, 0.f, 0.f, 0.f};
        cur = nxt; cA = nA; cB = nB; ++ui;
        if constexpr (ALIGN_EPI) { if (wr == 1) PG8_BAR; }
    }
    PG8_WAIT_V(0);
    if constexpr (!ALIGN_EPI) { if (wr == 0) PG8_BAR; }
    PG8_BAR;
    if constexpr (Epi::AFTER_DRAIN) { E.fused(acc, cur, wr, wc, fr, fq, lds, wid, lane); S.done(cur); }
#undef PG8_SA
#undef PG8_SB
#undef PG8_STAGE
#undef PG8_LDA
#undef PG8_LDB
#undef PG8_MMA
#undef PG8_WAIT_V
#undef PG8_WAIT_L
#undef PG8_BAR
#undef PG8_SCHED
}
}

constexpr int NWAVES = 8, NTHR = 512;
constexpr int D = 1024, MCTX = 8192, MLAT = 16384, M = MCTX + MLAT;
constexpr int TCTX = 256, TLAT = 4096, BCTX = 32, BLAT = 4, NH = 16, HD = 64;
constexpr int DIN = 7552, CRW = 3456, ZRN = 3584, DFF = 4096;
constexpr int NLAYER = 2;
constexpr float EPS = 1e-6f, GN_EPS = 64e-5f, DECAY_SCALE = 0.6065306597126334f;
enum { I_XP = 0, I_XS, I_STATE, I_C, I_CCTX, I_WADA, I_BADA, I_N1G, I_N2G, I_WIN, I_MU, I_W0, I_WUP, I_A0, I_AUP, I_GUP, I_KK, I_KA, I_RK, I_LNXG, I_LNXB, I_WBA, I_LNVG, I_WS, I_BS, I_WBB, I_WOUT, I_W1, I_W2, I_FING, N_IN };

constexpr size_t MiB = 1u << 20;
constexpr size_t WS_CTL = 0, CTL_ZERO_BYTES = 1 * MiB;
constexpr size_t WS_MOD = 1 * MiB;
constexpr size_t WS_BON = 2 * MiB;
constexpr size_t WS_SMALL = 4 * MiB;
constexpr size_t SM_WUP = 0, SM_AUP = 524288, SM_GUP = 1048576, SM_WS = 1572864;
constexpr size_t WS_W16 = 8 * MiB;
constexpr size_t W_INR = 0, W_INUV = (size_t)3584 * 1024, W_ING = (size_t)5632 * 1024, W_A = (size_t)7680 * 1024, W_B = (size_t)8704 * 1024, W_OUT = (size_t)9728 * 1024,
                 W_1 = (size_t)10752 * 1024, W_2 = (size_t)14848 * 1024, W_END = (size_t)18944 * 1024;
constexpr size_t WS_B = 48 * MiB;
constexpr size_t WS_BIG = 96 * MiB;
constexpr size_t WS_END = 288 * MiB;
static_assert(WS_W16 + W_END * 2 <= WS_B && WS_BIG + (size_t)M * DFF * 2 <= WS_END && (size_t)M * ZRN * 2 <= 192 * MiB, "ws map");

constexpr int RING_BYTES = 131072;
constexpr int LDS_BYTES = 147456;

#define LAS __attribute__((address_space(3)))
typedef _Float16 f16;
typedef _Float16 f16x4 __attribute__((ext_vector_type(4)));
typedef _Float16 f16x8 __attribute__((ext_vector_type(8)));
typedef float f32x4 __attribute__((ext_vector_type(4)));
typedef unsigned u32x2 __attribute__((ext_vector_type(2)));
typedef unsigned u32x4 __attribute__((ext_vector_type(4)));
typedef short v4i16_t __attribute__((ext_vector_type(4)));
using pg8::pk_f16; using pg8::f16lo; using pg8::f16hi; using pg8::fast_sigmoid;

struct Args { const float* in[N_IN]; float* out; unsigned char* ws; int ph_lo, ph_hi; };
static_assert(sizeof(Args) == N_IN * 8 + 8 + 8 + 8, "Args has no padding");

__device__ __forceinline__ float wave_sum(float v) {
#pragma unroll
    for (int o = 1; o < 64; o <<= 1) v += __shfl_xor(v, o);
    return v;
}
#define LDS_WAIT() asm volatile("s_waitcnt lgkmcnt(0)" ::: "memory")

__host__ __device__ __forceinline__ int perm_o(int p) { return 4 * (p & 15) + (p >> 4); }
__host__ __device__ __forceinline__ int perm_inv(int c) { return ((c & 3) << 4) + (c >> 2); }
__device__ __forceinline__ void transpose_item(const float* W, int K, int N, f16* WT, int split, int split_add, int permn_below, bool permk, LAS float* scr, int item, int lane) {
    const int nblk = N / 32, kb = item / nblk, nb = item % nblk, k0 = 64 * kb, n0 = 32 * nb;
#pragma unroll 8
    for (int i = 0; i < 32; ++i) { const int kk = 2 * i + (lane >> 5); const int ks = permk ? perm_o(kk) : kk; scr[kk * 33 + (lane & 31)] = W[(size_t)(k0 + ks) * N + n0 + (lane & 31)]; }
    LDS_WAIT(); asm volatile("" ::: "memory");
    const int c = lane & 7;
#pragma unroll
    for (int j = 0; j < 4; ++j) { const int n = (lane >> 3) + 8 * j; const LAS float* s = scr + (8 * c) * 33 + n; const int ng = n0 + n;
        const int drow = ng < permn_below ? (ng & ~63) + perm_inv(ng & 63) : ng + (ng >= split ? split_add : 0);
        u32x4 o; o.x = pk_f16(s[0 * 33], s[1 * 33]); o.y = pk_f16(s[2 * 33], s[3 * 33]); o.z = pk_f16(s[4 * 33], s[5 * 33]); o.w = pk_f16(s[6 * 33], s[7 * 33]);
        *(u32x4*)(WT + (size_t)drow * K + k0 + 8 * c) = o; }
    LDS_WAIT(); asm volatile("" ::: "memory");
}
__device__ __forceinline__ void convert_layer_weights(const Args& a, int z, int l, LAS unsigned char* lds, int gw, int ngw, int wave, int lane, int gtid, int ngt) {
    LAS float* scr = (LAS float*)(lds + wave * 16384);
    f16* W16 = (f16*)(a.ws + WS_W16);
    constexpr int I_IN = 16 * (DIN / 32), I_SQ = 16 * 32, I_1 = 16 * (DFF / 32), I_2 = (DFF / 64) * 32;
    constexpr int NITEMS = I_IN + 3 * I_SQ + I_1 + I_2;
    for (int it = gw; it < NITEMS; it += ngw) {
        int r = it;
        if (r < I_IN) { transpose_item(a.in[z + I_WIN] + (size_t)l * D * DIN, D, DIN, W16 + W_INR, CRW, 128, CRW, false, scr, r, lane); continue; } r -= I_IN;
        if (r < I_SQ) { transpose_item(a.in[z + I_WBA] + (size_t)l * D * D, D, D, W16 + W_A, 1 << 30, 0, 0, true, scr, r, lane); continue; } r -= I_SQ;
        if (r < I_SQ) { transpose_item(a.in[z + I_WBB] + (size_t)l * D * D, D, D, W16 + W_B, 1 << 30, 0, 0, false, scr, r, lane); continue; } r -= I_SQ;
        if (r < I_SQ) { transpose_item(a.in[z + I_WOUT] + (size_t)l * D * D, D, D, W16 + W_OUT, 1 << 30, 0, 0, false, scr, r, lane); continue; } r -= I_SQ;
        if (r < I_1) { transpose_item(a.in[z + I_W1] + (size_t)l * D * DFF, D, DFF, W16 + W_1, 1 << 30, 0, 0, false, scr, r, lane); continue; } r -= I_1;
        transpose_item(a.in[z + I_W2] + (size_t)l * DFF * D, DFF, D, W16 + W_2, 1 << 30, 0, 0, false, scr, r, lane);
    }
    u32x4* pad = (u32x4*)(W16 + W_INR + (size_t)CRW * 1024);
    for (int i = gtid; i < 128 * 1024 / 8; i += ngt) pad[i] = (u32x4){0u, 0u, 0u, 0u};
}
__device__ __forceinline__ void p0_prologue(const Args& a, int z, LAS unsigned char* lds, int G, int bx, int tid, int wave, int lane) {
    const int gw = bx * NWAVES + wave, ngw = G * NWAVES, gtid = bx * NTHR + tid, ngt = G * NTHR;
    {
        LAS float* SC = (LAS float*)lds;
        LAS float* P = (LAS float*)(lds + 20480);
        float* MOD = (float*)(a.ws + WS_MOD);
        bool have_sc = false;
        for (int item = bx; item < NLAYER * 96; item += G) {
            if (!have_sc) {
                for (int i = tid; i < 5 * 1024; i += NTHR) { const float x = (i < 1024) ? a.in[z + I_CCTX][i] : a.in[z + I_C][i - 1024]; SC[i] = x * fast_sigmoid(x); }
                have_sc = true;
            }
            __syncthreads();
            const int l = item / 96, n0 = (item % 96) * 64;
            const float* wp = a.in[z + I_WADA] + ((size_t)l * 1024 + wave * 128) * 6144 + n0 + lane;
            float acc[5] = {0.f, 0.f, 0.f, 0.f, 0.f};
#pragma unroll 8
            for (int kk = 0; kk < 128; ++kk) { const float wv = wp[(size_t)kk * 6144]; const int k = wave * 128 + kk;
#pragma unroll
                for (int s = 0; s < 5; ++s) acc[s] += SC[s * 1024 + k] * wv; }
#pragma unroll
            for (int s = 0; s < 5; ++s) P[(wave * 5 + s) * 64 + lane] = acc[s];
            __syncthreads();
            if (tid < 320) { const int s = tid >> 6, ln = tid & 63; float v = a.in[z + I_BADA][l * 6144 + n0 + ln];
#pragma unroll
                for (int w = 0; w < 8; ++w) v += P[(w * 5 + s) * 64 + ln];
                MOD[((size_t)l * 5 + s) * 6144 + n0 + ln] = v; }
        }
        __syncthreads();
    }
    {
        LAS float* scr = (LAS float*)(lds + wave * 16384);
        unsigned char* sm = a.ws + WS_SMALL;
        for (int it = gw; it < 128 + 128 + 128; it += ngw) {
            if (it < 128) { const int ld = it >> 5; transpose_item(a.in[z + I_WUP] + (size_t)ld * 64 * 1024, 64, 1024, (f16*)(sm + SM_WUP) + (size_t)ld * 1024 * 64, 1 << 30, 0, 0, true, scr, it & 31, lane); }
            else if (it < 256) { const int ld = (it - 128) >> 5; transpose_item(a.in[z + I_AUP] + (size_t)ld * 64 * 1024, 64, 1024, (f16*)(sm + SM_AUP) + (size_t)ld * 1024 * 64, 1 << 30, 0, 0, true, scr, it & 31, lane); }
            else { const int l = (it - 256) >> 6; transpose_item(a.in[z + I_GUP] + (size_t)l * 128 * 1024, 128, 1024, (f16*)(sm + SM_GUP) + (size_t)l * 1024 * 128, 1 << 30, 0, 0, true, scr, it & 63, lane); }
        }
        f16* ws16 = (f16*)(sm + SM_WS); const float* wsrc = a.in[z + I_WS];
        for (int i = gtid; i < NLAYER * 8 * 128 * 128 / 4; i += ngt) { const f32x4 v = *(const f32x4*)(wsrc + (size_t)i * 4); u32x2 o; o.x = pk_f16(v[0], v[1]); o.y = pk_f16(v[2], v[3]); *(u32x2*)(ws16 + (size_t)i * 4) = o; }
    }
    convert_layer_weights(a, z, 0, lds, gw, ngw, wave, lane, gtid, ngt);
}

__device__ __forceinline__ const float* xrow_ptr(const float* base_ctx, const float* base_lat, int row) { return row < MCTX ? base_ctx + (size_t)row * D : base_lat + (size_t)(row - MCTX) * D; }
__device__ __forceinline__ int row_stream(int row) { return row < MCTX ? 0 : 1 + ((row - MCTX) >> 12); }
__device__ __forceinline__ void norm_phase(const float* base_ctx, const float* base_lat, const float* gain, const float* modl, int sh_idx, int sc_idx, f16* H, int gw, int ngw, int lane) {
    const int rpw = (M + ngw - 1) / ngw; const int r0 = gw * rpw, r1 = (r0 + rpw < M) ? r0 + rpw : M;
    int cur_s = -1; f32x4 gm[4], sh[4];
    f32x4 nv[4];
    if (r0 < r1) { const f32x4* xn = (const f32x4*)xrow_ptr(base_ctx, base_lat, r0) + lane;
#pragma unroll
        for (int j = 0; j < 4; ++j) nv[j] = xn[64 * j]; }
    for (int row = r0; row < r1; ++row) {
        const int s = row_stream(row);
        if (s != cur_s) { cur_s = s;
#pragma unroll
            for (int j = 0; j < 4; ++j) { const int c = 4 * lane + 256 * j; const f32x4 g = *(const f32x4*)(gain + c); const f32x4 sc = *(const f32x4*)(modl + (size_t)s * 6144 + sc_idx * 1024 + c);
                gm[j] = g * (sc + 1.0f); sh[j] = *(const f32x4*)(modl + (size_t)s * 6144 + sh_idx * 1024 + c); } }
        f32x4 v[4]; float ss = 0.f;
#pragma unroll
        for (int j = 0; j < 4; ++j) v[j] = nv[j];
        { const int rn = (row + 1 < r1) ? row + 1 : row; const f32x4* xn = (const f32x4*)xrow_ptr(base_ctx, base_lat, rn) + lane;
#pragma unroll
          for (int j = 0; j < 4; ++j) nv[j] = xn[64 * j]; }
#pragma unroll
        for (int j = 0; j < 4; ++j) ss += (v[j][0] * v[j][0] + v[j][1] * v[j][1]) + (v[j][2] * v[j][2] + v[j][3] * v[j][3]);
        const float rs = __builtin_amdgcn_rsqf(wave_sum(ss) * (1.0f / D) + EPS);
        u32x2* o = (u32x2*)(H + (size_t)row * D) + lane;
#pragma unroll
        for (int j = 0; j < 4; ++j) { const f32x4 y = v[j] * rs * gm[j] + sh[j]; u32x2 w; w.x = pk_f16(y[0], y[1]); w.y = pk_f16(y[2], y[3]); o[64 * j] = w; }
    }
}
__device__ __forceinline__ void final_norm_phase(float* X, const float* gain, int gw, int ngw, int lane) {
    f32x4 g[4];
#pragma unroll
    for (int j = 0; j < 4; ++j) g[j] = *(const f32x4*)(gain + 4 * lane + 256 * j);
    for (int row = gw; row < M; row += ngw) {
        f32x4* xr = (f32x4*)(X + (size_t)row * D) + lane;
        f32x4 v[4]; float ss = 0.f;
#pragma unroll
        for (int j = 0; j < 4; ++j) { v[j] = xr[64 * j]; ss += (v[j][0] * v[j][0] + v[j][1] * v[j][1]) + (v[j][2] * v[j][2] + v[j][3] * v[j][3]); }
        const float rs = __builtin_amdgcn_rsqf(wave_sum(ss) * (1.0f / D) + EPS);
#pragma unroll
        for (int j = 0; j < 4; ++j) xr[64 * j] = v[j] * rs * g[j];
    }
}

constexpr int SA_RH = 0, SA_KRH = 2304, SA_KNH = 4608, SA_WD = 6912, SA_AD = 9216, SA_GD = 11520, SA_SZ = 15872;
constexpr int L_SA = 0, L_VT = 31744, L_VS = 39424, L_AREF = 46336, L_RREF = 48640, L_BREF = 50944, L_KREF = 53248, L_A0T = 55552, L_R0 = 60672, L_BKT = 65280, L_EC = 75520,
              L_GF = 76032, L_BONP = 84736, L_AAB = 85248, L_AAK = 87296, L_UVT = 87808, L_APR = 92928, L_ARK = 95232, L_YO = 96512, L_MU = 100864, L_DIR = 102656;
static_assert(L_DIR <= LDS_BYTES, "scan LDS");
constexpr int HLD = 72;
constexpr int GD_LD = 136;
constexpr int TLD = 20;

#define FMAC_BC(acc, x, s, N) asm("v_fmac_f32_dpp %0, %1, %2 row_newbcast:" #N " row_mask:0xf bank_mask:0xf" : "+v"(acc) : "v"(x), "v"(s))
#define FS_COL(s) _Pragma("unroll") for (int t_ = s + 1; t_ < 16; ++t_) FMAC_BC(x[t_], arow[t_], x[s], s);
__device__ __forceinline__ void fwd_subst(float (&x)[16], const float (&arow)[16]) {
    FS_COL(0) FS_COL(1) FS_COL(2) FS_COL(3) FS_COL(4) FS_COL(5) FS_COL(6) FS_COL(7) FS_COL(8) FS_COL(9) FS_COL(10) FS_COL(11) FS_COL(12) FS_COL(13) FS_COL(14)
}
__device__ __forceinline__ float fast_tanh(float x) { return 1.0f - 2.0f * __builtin_amdgcn_rcpf(1.0f + __expf(2.0f * x)); }
template <int CTRL> __device__ __forceinline__ float dpp_f(float x) { return __builtin_bit_cast(float, __builtin_amdgcn_update_dpp(0, __builtin_bit_cast(int, x), CTRL, 0xf, 0xf, false)); }
__device__ __forceinline__ float red16(float v) { v += dpp_f<0x128>(v); v += dpp_f<0x124>(v); v += dpp_f<0x122>(v); v += dpp_f<0x121>(v); return v; }
__device__ __forceinline__ float h2f(unsigned short u) { return (float)__builtin_bit_cast(f16, u); }
__device__ __forceinline__ f32x4 tile_xyT(LAS unsigned char* X, LAS unsigned char* Y, int lane) {
    f32x4 acc = {0.f, 0.f, 0.f, 0.f};
    const int o = ((lane & 15) * HLD + 8 * (lane >> 4)) * 2;
#pragma unroll
    for (int ks = 0; ks < 2; ++ks) { const f16x8 fa = *(const LAS f16x8*)(X + o + 64 * ks), fb = *(const LAS f16x8*)(Y + o + 64 * ks); acc = __builtin_amdgcn_mfma_f32_16x16x32_f16(fa, fb, acc, 0, 0, 0); }
    return acc;
}

template <bool LAT> struct PreZ { u32x2 ctr[7]; u32x2 nbr[7]; };

template <bool LAT> __device__ __forceinline__ bool nbr_valid(int t, int q) {
    constexpr int T = LAT ? TLAT : TCTX;
    if (LAT) { const int col = t & 63, rw = t >> 6; return q == 0 ? col >= 1 : (q == 1 ? col < 63 : (q == 2 ? rw >= 1 : rw < 63)); }
    return (q & 1) ? (t + 1 < T) : (t >= 1);
}
template <bool LAT> __device__ __forceinline__ void pre_issue(PreZ<LAT>& P, const f16* Zr, size_t row_base, int c, int d, int h, int tg, bool want_g) {
    const int s = tg >> 4, g = tg & 15, q = g >> 2;
    const int t = 16 * c + (d ? 15 - s : s);
    const unsigned rowoff = (unsigned)((row_base + t) * (size_t)ZRN * 2 + 8 * g);
    const unsigned colb[7] = {(unsigned)(h * 128), (unsigned)(2048 + h * 128), (unsigned)(4096 + h * 128), (unsigned)(6144 + d * 128), (unsigned)(6400 + d * 128), 6656u, 6784u};
    const char* zb = (const char*)Zr;
    constexpr unsigned RS = ZRN * 2;
    unsigned dn;
    if (LAT) dn = q == 0 ? 0u - RS : (q == 1 ? RS : (q == 2 ? 0u - 64u * RS : 64u * RS));
    else dn = (q & 1) ? RS : 0u - RS;
    if (!nbr_valid<LAT>(t, q)) dn = 0u;
#pragma unroll
    for (int a = 0; a < 7; ++a) { const unsigned o = rowoff + colb[a];
        if (a >= 5 && !want_g) continue;
        P.ctr[a] = *(const u32x2*)(zb + o);
        P.nbr[a] = *(const u32x2*)(zb + (o + dn)); }
}
typedef _Float16 h2_t __attribute__((ext_vector_type(2)));
template <bool LAT> __device__ __forceinline__ u32x2 pre_mix(const PreZ<LAT>& P, int a, const u32x2 mu, bool valid) {
    const unsigned cx_ = P.ctr[a][0], cy_ = P.ctr[a][1], nx_ = valid ? P.nbr[a][0] : 0u, ny_ = valid ? P.nbr[a][1] : 0u, mx_ = mu[0], my_ = mu[1];
    const h2_t z0 = __builtin_bit_cast(h2_t, cx_);
    const h2_t z1 = __builtin_bit_cast(h2_t, cy_);
    const h2_t n0 = __builtin_bit_cast(h2_t, nx_);
    const h2_t n1 = __builtin_bit_cast(h2_t, ny_);
    const h2_t m0 = __builtin_bit_cast(h2_t, mx_);
    const h2_t m1 = __builtin_bit_cast(h2_t, my_);
    const h2_t r0 = z0 + m0 * (n0 - z0);
    const h2_t r1 = z1 + m1 * (n1 - z1);
    u32x2 r; r[0] = __builtin_bit_cast(unsigned, r0); r[1] = __builtin_bit_cast(unsigned, r1); return r;
}

template <bool LAT> __device__ __forceinline__ void scan_chain(const Args& a, int z, int l, LAS unsigned char* lds, int unit, int b, int h, int d, int tid, int wave, int lane, const unsigned* mid_cnt = nullptr) {
    constexpr int T = LAT ? TLAT : TCTX, NT = T / 16;
    const size_t row_base = LAT ? (size_t)MCTX + (size_t)b * TLAT : (size_t)b * TCTX;
    const f16* Zr = (const f16*)(a.ws + WS_BIG);
    f16* YA = l == 0 ? (f16*)a.out : (f16*)(a.ws + WS_B);
    float* BONG = (float*)(a.ws + WS_BON);
    unsigned* flag_mine = (unsigned*)(a.ws + WS_CTL) + 1024 + (((size_t)l * 576 + unit) * 2 + d) * 16;
    unsigned* flag_partner = (unsigned*)(a.ws + WS_CTL) + 1024 + (((size_t)l * 576 + unit) * 2 + (d ^ 1)) * 16;
    const bool helper = wave >= 4;
    const int q = wave & 3, tg = tid & 255, g4 = lane >> 4, c16 = lane & 15;
    LAS unsigned char* Ld = lds;
    const unsigned char* sm = a.ws + WS_SMALL;
    const int jl = 16 * q + c16;
    const int lcol = h * 64 + perm_o(jl), kq = 8 * g4;
    const f16* gu = (const f16*)(sm + SM_GUP) + ((size_t)l * 1024 + lcol) * 128 + kq;
    const f16* wu = (const f16*)(sm + SM_WUP) + ((size_t)(l * 2 + d) * 1024 + lcol) * 64 + kq;
    const f16* au = (const f16*)(sm + SM_AUP) + ((size_t)(l * 2 + d) * 1024 + lcol) * 64 + kq;
    const float* w0p = a.in[z + I_W0] + (size_t)(l * 2 + d) * 1024 + lcol; const float* a0p = a.in[z + I_A0] + (size_t)(l * 2 + d) * 1024 + lcol;
    const float* kap = a.in[z + I_KA] + l * 1024 + lcol; const float* rkp = a.in[z + I_RK] + l * 1024 + lcol;
    const int sA = tg >> 4, gA = tg & 15;
    const int chA = h * 64 + 4 * gA;
    if (helper && sA == 0) {
        const float* mu = a.in[z + I_MU] + (size_t)l * CRW;
        const int colbase[7] = {h * 64 + 4 * gA, 1024 + h * 64 + 4 * gA, 2048 + h * 64 + 4 * gA, 3072 + d * 64 + 4 * gA, 3200 + d * 64 + 4 * gA, 3328 + 4 * gA, 3392 + 4 * gA};
#pragma unroll
        for (int i = 0; i < 7; ++i) { const float* mb = mu + (colbase[i] - 4 * gA);
            u32x2 w; w.x = pk_f16(mb[perm_o(4 * gA)], mb[perm_o(4 * gA + 1)]); w.y = pk_f16(mb[perm_o(4 * gA + 2)], mb[perm_o(4 * gA + 3)]); *(LAS u32x2*)(Ld + L_MU + (i * 64 + 4 * gA) * 2) = w; }
    }
#define MUV(i) (*(const LAS u32x2*)(Ld + L_MU + ((i) * 64 + 4 * gA) * 2))
    f32x4 kkc4, lng4, lnb4;
#pragma unroll
    for (int e = 0; e < 4; ++e) { const int co = l * 1024 + h * 64 + perm_o(4 * gA + e); kkc4[e] = a.in[z + I_KK][co]; lng4[e] = a.in[z + I_LNXG][co]; lnb4[e] = a.in[z + I_LNXB][co]; }
    const unsigned kkw0_ = pk_f16(kkc4[0], kkc4[1]), kkw1_ = pk_f16(kkc4[2], kkc4[3]);
    const h2_t kkh0 = __builtin_bit_cast(h2_t, kkw0_);
    const h2_t kkh1 = __builtin_bit_cast(h2_t, kkw1_);
    float S[16];
    const size_t sidx = ((((size_t)b * 2 + l) * 2 + d) * 16 + h) * 4096 + (size_t)perm_o(16 * q + c16) * 64;
    if (LAT && !helper) { const float* sp = a.in[z + I_STATE] + sidx;
#pragma unroll
        for (int n = 0; n < 16; ++n) S[n] = sp[perm_o(32 * (n >> 3) + 8 * g4 + (n & 7))]; }
    else {
#pragma unroll
        for (int n = 0; n < 16; ++n) S[n] = 0.f; }
    for (int i = tid; i < 5120 / 4; i += NTHR) { *(LAS unsigned*)(Ld + L_BKT + 5120 + 4 * i) = 0u; *(LAS unsigned*)(Ld + L_UVT + 4 * i) = 0u; }
    for (int i = tid; i < 2304 / 4; i += NTHR) { *(LAS unsigned*)(Ld + L_R0 + 2304 + 4 * i) = 0u; *(LAS unsigned*)(Ld + L_APR + 4 * i) = 0u; }
    for (int i = tid; i < 1280 / 4; i += NTHR) *(LAS unsigned*)(Ld + L_ARK + 4 * i) = 0u;
    for (int i = tid; i < 2560 / 4; i += NTHR) *(LAS unsigned*)(Ld + L_VT + 2 * 2560 + 4 * i) = 0u;
    if (tid < 64) *(LAS float*)(Ld + L_EC + 256 + 4 * tid) = 1.0f;
    __syncthreads();
    PreZ<LAT> PA, PB;
    u32x2 yprev = {0u, 0u}; float bgprev = 0.f; bool flag_ok = false;

#define STAGE_A(nA, PX) do { const int cA_ = d ? NT - 1 - (nA) : (nA); const int vb = (nA) % 3; LAS unsigned char* SAw = Ld + L_SA + ((nA) & 1) * SA_SZ; const int tA = 16 * cA_ + (d ? 15 - sA : sA); const bool vA = nbr_valid<LAT>(tA, gA >> 2); \
            const u32x2 zr = pre_mix<LAT>(PX, 0, MUV(0), vA), zk = pre_mix<LAT>(PX, 1, MUV(1), vA), zv = pre_mix<LAT>(PX, 2, MUV(2), vA), zw = pre_mix<LAT>(PX, 3, MUV(3), vA), za = pre_mix<LAT>(PX, 4, MUV(4), vA); \
            const int o8 = (sA * HLD + 4 * gA) * 2; \
            *(LAS u32x2*)(SAw + SA_RH + o8) = zr; \
            *(LAS u32x2*)(SAw + SA_KRH + o8) = zk; \
            { const unsigned zk0_ = zk[0], zk1_ = zk[1]; const h2_t k0 = __builtin_bit_cast(h2_t, zk0_) * kkh0; const h2_t k1 = __builtin_bit_cast(h2_t, zk1_) * kkh1; \
              const float ss = red16(__builtin_amdgcn_fdot2(k0, k0, __builtin_amdgcn_fdot2(k1, k1, 0.f, false), false)); const float rn = __builtin_amdgcn_rsqf(ss + 1e-12f); \
              u32x2 w; w.x = pk_f16((float)k0.x * rn, (float)k0.y * rn); w.y = pk_f16((float)k1.x * rn, (float)k1.y * rn); *(LAS u32x2*)(SAw + SA_KNH + o8) = w; } \
            { const u32x2 w = zv; *(LAS u32x2*)(Ld + L_VS + vb * 2304 + o8) = w; \
              *(LAS unsigned short*)(Ld + L_VT + vb * 2560 + ((4 * gA + 0) * TLD + sA) * 2) = (unsigned short)(w.x & 0xffffu); *(LAS unsigned short*)(Ld + L_VT + vb * 2560 + ((4 * gA + 1) * TLD + sA) * 2) = (unsigned short)(w.x >> 16); \
              *(LAS unsigned short*)(Ld + L_VT + vb * 2560 + ((4 * gA + 2) * TLD + sA) * 2) = (unsigned short)(w.y & 0xffffu); *(LAS unsigned short*)(Ld + L_VT + vb * 2560 + ((4 * gA + 3) * TLD + sA) * 2) = (unsigned short)(w.y >> 16); } \
            { u32x2 w; w.x = pk_f16(fast_tanh(f16lo(zw.x)), fast_tanh(f16hi(zw.x))); w.y = pk_f16(fast_tanh(f16lo(zw.y)), fast_tanh(f16hi(zw.y))); *(LAS u32x2*)(SAw + SA_WD + o8) = w; } \
            *(LAS u32x2*)(SAw + SA_AD + o8) = za; \
            if ((nA) >= NT / 2) { \
                const u32x2 g0 = pre_mix<LAT>(PX, 5, MUV(5), vA), g1 = pre_mix<LAT>(PX, 6, MUV(6), vA); \
                u32x2 w; w.x = pk_f16(fast_sigmoid(f16lo(g0.x)), fast_sigmoid(f16hi(g0.x))); w.y = pk_f16(fast_sigmoid(f16lo(g0.y)), fast_sigmoid(f16hi(g0.y))); *(LAS u32x2*)(SAw + SA_GD + (sA * GD_LD + 4 * gA) * 2) = w; \
                w.x = pk_f16(fast_sigmoid(f16lo(g1.x)), fast_sigmoid(f16hi(g1.x))); w.y = pk_f16(fast_sigmoid(f16lo(g1.y)), fast_sigmoid(f16hi(g1.y))); *(LAS u32x2*)(SAw + SA_GD + (sA * GD_LD + 64 + 4 * gA) * 2) = w; \
            } } while (0)
#define FINALIZE(nF) do { const bool finp = ((nF) >= NT / 2); const int cp = d ? NT - 1 - (nF) : (nF); const int pb = (nF) & 1; const int v3 = (nF) % 3; \
            const size_t row = row_base + (size_t)(16 * cp + (d ? 15 - sA : sA)); \
            const f32x4 yv = *(const LAS f32x4*)(Ld + L_YO + (sA * 68 + 4 * gA) * 4); \
            LAS unsigned char* bp = Ld + L_BONP + pb * 256; \
            const float bon = *(LAS float*)(bp + (0 * 16 + sA) * 4) + *(LAS float*)(bp + (1 * 16 + sA) * 4) + *(LAS float*)(bp + (2 * 16 + sA) * 4) + *(LAS float*)(bp + (3 * 16 + sA) * 4); \
            unsigned long long* yp = (unsigned long long*)(YA + row * D + chA); \
            if (!finp) { const unsigned long long w = (unsigned long long)pk_f16(yv[0], yv[1]) | ((unsigned long long)pk_f16(yv[2], yv[3]) << 32); \
                __hip_atomic_store(yp, w, __ATOMIC_RELAXED, __HIP_MEMORY_SCOPE_AGENT); if (gA == 0) __hip_atomic_store(BONG + row * 16 + h, bon, __ATOMIC_RELAXED, __HIP_MEMORY_SCOPE_AGENT); } \
            else { \
                const f32x4 y = {yv[0] + f16lo(yprev.x), yv[1] + f16hi(yprev.x), yv[2] + f16lo(yprev.y), yv[3] + f16hi(yprev.y)}; \
                const float mean = red16((y[0] + y[1]) + (y[2] + y[3])) * (1.0f / 64.0f); const f32x4 dv = y - mean; \
                const float var = red16((dv[0] * dv[0] + dv[1] * dv[1]) + (dv[2] * dv[2] + dv[3] * dv[3])) * (1.0f / 64.0f); \
                const f32x4 yn = dv * __builtin_amdgcn_rsqf(var + GN_EPS) * lng4 + lnb4; \
                const u32x2 vw = *(const LAS u32x2*)(Ld + L_VS + v3 * 2304 + (sA * HLD + 4 * gA) * 2); const f32x4 vv = {f16lo(vw.x), f16hi(vw.x), f16lo(vw.y), f16hi(vw.y)}; \
                const f32x4 gg = *(const LAS f32x4*)(Ld + L_GF + pb * 4352 + (sA * 68 + 4 * gA) * 4); \
                const f32x4 o = (yn + (bon + bgprev) * vv) * gg; \
                u32x2 w; w.x = pk_f16(o[0], o[1]); w.y = pk_f16(o[2], o[3]); *(u32x2*)yp = w; \
            } } while (0)

    if (helper) {
        pre_issue<LAT>(PA, Zr, row_base, d ? NT - 1 : 0, d, h, tg, NT / 2 <= 0);
        pre_issue<LAT>(PB, Zr, row_base, d ? NT - 2 : 1, d, h, tg, NT / 2 <= 1);
        STAGE_A(0, PA);
        pre_issue<LAT>(PA, Zr, row_base, d ? NT - 3 : 2, d, h, tg, NT / 2 <= 2);
        bool have_prev = false;
        __syncthreads();
#pragma unroll 1
        for (int n2_ = 0; n2_ < NT / 2; ++n2_) {
            int n2 = n2_; asm volatile("" : "+v"(n2)); n2 = __builtin_amdgcn_readfirstlane(n2);
#pragma unroll
        for (int par_ = 0; par_ < 2; ++par_) {
            const int n = 2 * n2 + par_;
            if (tid == 256 && n == NT / 2 + 1) __hip_atomic_store(flag_mine, (unsigned)(NT / 2), __ATOMIC_RELAXED, __HIP_MEMORY_SCOPE_AGENT);
            if (n + 1 < NT) { if (par_ == 0) STAGE_A(n + 1, PB); else STAGE_A(n + 1, PA); }
            __syncthreads();
            if (n > 0) {
                if (n - 1 >= NT / 2 && !have_prev) {
                    const int mP = n - 1;
                    if (!flag_ok) { unsigned spins = 0; while (__hip_atomic_load(flag_partner, __ATOMIC_RELAXED, __HIP_MEMORY_SCOPE_AGENT) < (unsigned)(NT / 2)) { __builtin_amdgcn_s_sleep(4); if (++spins > (1u << 22)) break; }
                        __builtin_amdgcn_fence(__ATOMIC_ACQUIRE, "agent"); flag_ok = true; }
                    const size_t rowp_ = row_base + (size_t)(16 * (d ? NT - 1 - mP : mP) + (d ? 15 - sA : sA));
                    const unsigned long long wq_ = __hip_atomic_load((const unsigned long long*)(YA + rowp_ * D + chA), __ATOMIC_RELAXED, __HIP_MEMORY_SCOPE_AGENT);
                    yprev.x = (unsigned)wq_; yprev.y = (unsigned)(wq_ >> 32);
                    bgprev = __hip_atomic_load(BONG + rowp_ * 16 + h, __ATOMIC_RELAXED, __HIP_MEMORY_SCOPE_AGENT);
                }
                FINALIZE(n - 1);
                if (n == NT / 2) asm volatile("s_waitcnt vmcnt(0)" ::: "memory");
            }
            have_prev = false;
            if (n >= NT / 2 && flag_ok) {
                    const int mP = n;
                    const size_t rowp_ = row_base + (size_t)(16 * (d ? NT - 1 - mP : mP) + (d ? 15 - sA : sA));
                    const unsigned long long wq_ = __hip_atomic_load((const unsigned long long*)(YA + rowp_ * D + chA), __ATOMIC_RELAXED, __HIP_MEMORY_SCOPE_AGENT);
                    yprev.x = (unsigned)wq_; yprev.y = (unsigned)(wq_ >> 32);
                    bgprev = __hip_atomic_load(BONG + rowp_ * 16 + h, __ATOMIC_RELAXED, __HIP_MEMORY_SCOPE_AGENT);
                    have_prev = true; }
            asm volatile("" ::: "memory");
            if (LAT && mid_cnt != nullptr && (n + 3 == 28 || n + 3 == 60)) {
                const unsigned* cw = mid_cnt + (n + 3 == 60 ? 64 : 0);
                unsigned spins = 0; while (__hip_atomic_load(cw, __ATOMIC_RELAXED, __HIP_MEMORY_SCOPE_AGENT) < 128u) { __builtin_amdgcn_s_sleep(8); if (++spins > (1u << 22)) break; }
                __builtin_amdgcn_fence(__ATOMIC_ACQUIRE, "agent"); }
            { const int nn = (n + 3 < NT) ? n + 3 : NT - 1;
              if (par_ == 0) pre_issue<LAT>(PB, Zr, row_base, d ? NT - 1 - nn : nn, d, h, tg, nn >= NT / 2); else pre_issue<LAT>(PA, Zr, row_base, d ? NT - 1 - nn : nn, d, h, tg, nn >= NT / 2); }
            __syncthreads();
        }
        }
        __syncthreads();
        if (!have_prev) {
                    const int mP = NT - 1;
                    if (!flag_ok) { unsigned spins = 0; while (__hip_atomic_load(flag_partner, __ATOMIC_RELAXED, __HIP_MEMORY_SCOPE_AGENT) < (unsigned)(NT / 2)) { __builtin_amdgcn_s_sleep(4); if (++spins > (1u << 22)) break; }
                        __builtin_amdgcn_fence(__ATOMIC_ACQUIRE, "agent"); flag_ok = true; }
                    const size_t rowp_ = row_base + (size_t)(16 * (d ? NT - 1 - mP : mP) + (d ? 15 - sA : sA));
                    const unsigned long long wq_ = __hip_atomic_load((const unsigned long long*)(YA + rowp_ * D + chA), __ATOMIC_RELAXED, __HIP_MEMORY_SCOPE_AGENT);
                    yprev.x = (unsigned)wq_; yprev.y = (unsigned)(wq_ >> 32);
                    bgprev = __hip_atomic_load(BONG + rowp_ * 16 + h, __ATOMIC_RELAXED, __HIP_MEMORY_SCOPE_AGENT);
        }
        FINALIZE(NT - 1);
    } else {
        __builtin_amdgcn_s_setprio(2);
        f16x8 wupB[2], aupB[2], gupB[4];
#pragma unroll
        for (int ks = 0; ks < 2; ++ks) { wupB[ks] = *(const f16x8*)(wu + 32 * ks); aupB[ks] = *(const f16x8*)(au + 32 * ks); }
#pragma unroll
        for (int ks = 0; ks < 4; ++ks) gupB[ks] = *(const f16x8*)(gu + 32 * ks);
        const float w0v = *w0p, a0v = *a0p, kac = *kap, rkc = *rkp;
        __syncthreads();
#pragma unroll 1
        for (int n_ = 0; n_ < NT; ++n_) {
            int n = n_; asm volatile("" : "+v"(n)); n = __builtin_amdgcn_readfirstlane(n);
            const bool fin = (n >= NT / 2);
            const int pbn = n & 1, v3n = n % 3;
            LAS unsigned char* SAb = Ld + L_SA + pbn * SA_SZ;
            {
            const int pbm = (n + 1) & 1, v3m = (n + 2) % 3;
            f16x8 sb[2];
#pragma unroll
            for (int ks = 0; ks < 2; ++ks) { u32x4 w; w.x = pk_f16(S[8 * ks], S[8 * ks + 1]); w.y = pk_f16(S[8 * ks + 2], S[8 * ks + 3]); w.z = pk_f16(S[8 * ks + 4], S[8 * ks + 5]); w.w = pk_f16(S[8 * ks + 6], S[8 * ks + 7]); sb[ks] = __builtin_bit_cast(f16x8, w); }
            const int il = 16 * q + c16;
            f32x4 U = *(const LAS f32x4*)(Ld + L_UVT + (il * TLD + 4 * g4) * 4);
            f32x4 Y = {0.f, 0.f, 0.f, 0.f};
            const int oa = (c16 * HLD + 8 * g4) * 2;
#pragma unroll
            for (int ks = 0; ks < 2; ++ks) {
                const f16x8 fap = *(const LAS f16x8*)(Ld + L_APR + oa + 64 * ks), fr0 = *(const LAS f16x8*)(Ld + L_R0 + pbm * 2304 + oa + 64 * ks);
                U = __builtin_amdgcn_mfma_f32_16x16x32_f16(fap, sb[ks], U, 0, 0, 0);
                Y = __builtin_amdgcn_mfma_f32_16x16x32_f16(fr0, sb[ks], Y, 0, 0, 0);
            }
            f16x8 uvb; { const u32x2 wv_ = *(const LAS u32x2*)(Ld + L_VT + v3m * 2560 + (il * TLD + 4 * g4) * 2); const u32x4 w4 = {pk_f16(U[0], U[1]), pk_f16(U[2], U[3]), wv_.x, wv_.y}; uvb = __builtin_bit_cast(f16x8, w4); }
            { const f16x8 fark = *(const LAS f16x8*)(Ld + L_ARK + (c16 * 40 + 8 * g4) * 2); Y = __builtin_amdgcn_mfma_f32_16x16x32_f16(fark, uvb, Y, 0, 0, 0); }
#pragma unroll
            for (int r = 0; r < 4; ++r) *(LAS float*)(Ld + L_YO + ((4 * g4 + r) * 68 + il) * 4) = Y[r];
#pragma unroll
            for (int jt = 0; jt < 4; ++jt) {
                const int jo = 32 * (jt >> 1) + 8 * (c16 >> 2) + 4 * (jt & 1) + (c16 & 3);
                const f16x8 fbk = *(const LAS f16x8*)(Ld + L_BKT + pbm * 5120 + (jo * 40 + 8 * g4) * 2);
                const f32x4 ec = *(const LAS f32x4*)(Ld + L_EC + pbm * 256 + (32 * (jt >> 1) + 8 * g4 + 4 * (jt & 1)) * 4);
                const int sbase = 8 * (jt >> 1) + 4 * (jt & 1);
                f32x4 cin = {S[sbase] * ec[0], S[sbase + 1] * ec[1], S[sbase + 2] * ec[2], S[sbase + 3] * ec[3]};
                cin = __builtin_amdgcn_mfma_f32_16x16x32_f16(fbk, uvb, cin, 0, 0, 0);
                S[sbase] = cin[0]; S[sbase + 1] = cin[1]; S[sbase + 2] = cin[2]; S[sbase + 3] = cin[3];
            }
            }
            {
            f32x4 cw = {0.f, 0.f, 0.f, 0.f}, ca = {0.f, 0.f, 0.f, 0.f};
#pragma unroll
            for (int ks = 0; ks < 2; ++ks) {
                const f16x8 fw = *(const LAS f16x8*)(SAb + SA_WD + (c16 * HLD + kq + 32 * ks) * 2);
                const f16x8 fa = *(const LAS f16x8*)(SAb + SA_AD + (c16 * HLD + kq + 32 * ks) * 2);
                cw = __builtin_amdgcn_mfma_f32_16x16x32_f16(fw, wupB[ks], cw, 0, 0, 0);
                ca = __builtin_amdgcn_mfma_f32_16x16x32_f16(fa, aupB[ks], ca, 0, 0, 0);
            }
            if (fin) {
                f32x4 cg_ = {0.f, 0.f, 0.f, 0.f};
#pragma unroll
                for (int ks = 0; ks < 4; ++ks) { const f16x8 fg = *(const LAS f16x8*)(SAb + SA_GD + (c16 * GD_LD + kq + 32 * ks) * 2); cg_ = __builtin_amdgcn_mfma_f32_16x16x32_f16(fg, gupB[ks], cg_, 0, 0, 0); }
#pragma unroll
                for (int r = 0; r < 4; ++r) *(LAS float*)(Ld + L_GF + pbn * 4352 + ((4 * g4 + r) * 68 + jl) * 4) = cg_[r];
            }
            float wv[4], av[4], rr[4], kd[4], kn[4];
#pragma unroll
            for (int r = 0; r < 4; ++r) { const int o = ((4 * g4 + r) * HLD + jl) * 2;
                wv[r] = __expf(-DECAY_SCALE * fast_sigmoid(w0v + cw[r])); av[r] = fast_sigmoid(a0v + ca[r]);
                rr[r] = (float)*(LAS f16*)(SAb + SA_RH + o); const float kr = (float)*(LAS f16*)(SAb + SA_KRH + o); kn[r] = (float)*(LAS f16*)(SAb + SA_KNH + o);
                kd[r] = kr * (1.0f + (av[r] - 1.0f) * kac); }
            float E[4]; E[0] = wv[0]; E[1] = E[0] * wv[1]; E[2] = E[1] * wv[2]; E[3] = E[2] * wv[3];
            float tt = E[3];
            { const float u1 = __shfl_up(tt, 16); if (g4 >= 1) tt *= u1; const float u2 = __shfl_up(tt, 32); if (g4 >= 2) tt *= u2; }
            float ex = __shfl_up(tt, 16); if (g4 == 0) ex = 1.0f;
            const float EC = __shfl(tt, 48 + c16), Emid = __shfl(tt, 16 + c16);
            const float c1 = __builtin_amdgcn_rcpf(Emid), c2 = Emid;
            float bonp[4]; float a0t[4]; unsigned short hBp[4], hKp[4];
#pragma unroll
            for (int r = 0; r < 4; ++r) {
                const float Ei = ex * E[r], Ep = (r == 0) ? ex : ex * E[r - 1], inv = __builtin_amdgcn_rcpf(Ei);
                const float aa = -kn[r], bb = av[r] * kn[r];
                a0t[r] = aa * Ep;
                hBp[r] = __builtin_bit_cast(unsigned short, (f16)(bb * inv * EC)); hKp[r] = __builtin_bit_cast(unsigned short, (f16)(kd[r] * inv * EC));
                bonp[r] = red16(kd[r] * rkc * rr[r]);
                const int o = ((4 * g4 + r) * HLD + jl) * 2;
                *(LAS f16*)(Ld + L_AREF + o) = (f16)(a0t[r] * c1); *(LAS f16*)(Ld + L_RREF + o) = (f16)(rr[r] * Ei * c1); *(LAS f16*)(Ld + L_BREF + o) = (f16)(bb * inv * c2); *(LAS f16*)(Ld + L_KREF + o) = (f16)(kd[r] * inv * c2);
                *(LAS f16*)(Ld + L_R0 + pbn * 2304 + o) = (f16)(rr[r] * Ei);
            }
            *(LAS f32x4*)(Ld + L_A0T + (jl * TLD + 4 * g4) * 4) = (f32x4){a0t[0], a0t[1], a0t[2], a0t[3]};
            { u32x4 w; w.x = hBp[0] | ((unsigned)hBp[1] << 16); w.y = hBp[2] | ((unsigned)hBp[3] << 16); w.z = hKp[0] | ((unsigned)hKp[1] << 16); w.w = hKp[2] | ((unsigned)hKp[3] << 16);
              *(LAS u32x4*)(Ld + L_BKT + pbn * 5120 + (jl * 40 + 8 * g4) * 2) = w; }
            if (g4 == 0) *(LAS float*)(Ld + L_EC + pbn * 256 + jl * 4) = EC;
            if (c16 == 0) {
#pragma unroll
                for (int r = 0; r < 4; ++r) *(LAS float*)(Ld + L_BONP + pbn * 256 + (q * 16 + 4 * g4 + r) * 4) = bonp[r]; }
            }
            __syncthreads();
            {
            if (q == 0) {
                const f32x4 ab = tile_xyT(Ld + L_AREF, Ld + L_BREF, lane);
#pragma unroll
                for (int r = 0; r < 4; ++r) *(LAS float*)(Ld + L_AAB + ((4 * g4 + r) * 16 + c16) * 4) = ab[r];
                float x[16], arow[16];
#pragma unroll
                for (int t4 = 0; t4 < 4; ++t4) { const f32x4 v = *(const LAS f32x4*)(Ld + L_A0T + (lane * TLD + 4 * t4) * 4); x[4 * t4] = v[0]; x[4 * t4 + 1] = v[1]; x[4 * t4 + 2] = v[2]; x[4 * t4 + 3] = v[3]; }
#pragma unroll
                for (int t = 0; t < 16; ++t) arow[t] = *(LAS float*)(Ld + L_AAB + (t * 16 + c16) * 4);
                fwd_subst(x, arow);
#pragma unroll
                for (int t = 0; t < 16; ++t) *(LAS f16*)(Ld + L_APR + (t * HLD + lane) * 2) = (f16)x[t];
            } else if (q == 1) {
                const f32x4 ab = tile_xyT(Ld + L_AREF, Ld + L_BREF, lane);
                const f32x4 ak = tile_xyT(Ld + L_AREF, Ld + L_KREF, lane);
#pragma unroll
                for (int r = 0; r < 4; ++r) { const int t = 4 * g4 + r; *(LAS float*)(Ld + L_AAB + 1024 + (t * 16 + c16) * 4) = ab[r]; *(LAS f16*)(Ld + L_AAK + (t * 16 + c16) * 2) = (f16)((c16 < t) ? ak[r] : 0.f); }
                f16x8 fa; { const u32x2 w = *(const LAS u32x2*)(Ld + L_AAK + (c16 * 16 + 4 * g4) * 2); const u32x4 w4 = {w.x, w.y, 0u, 0u}; fa = __builtin_bit_cast(f16x8, w4); }
#pragma unroll
                for (int it = 0; it < 4; ++it) {
                    const u32x2 wv_ = *(const LAS u32x2*)(Ld + L_VT + v3n * 2560 + ((16 * it + c16) * TLD + 4 * g4) * 2); const u32x4 w4 = {wv_.x, wv_.y, 0u, 0u};
                    f32x4 acc = {0.f, 0.f, 0.f, 0.f};
                    acc = __builtin_amdgcn_mfma_f32_16x16x32_f16(fa, __builtin_bit_cast(f16x8, w4), acc, 0, 0, 0);
                    *(LAS f32x4*)(Ld + L_UVT + ((16 * it + c16) * TLD + 4 * g4) * 4) = acc;
                }
                float x[16], arow[16];
#pragma unroll
                for (int t4 = 0; t4 < 4; ++t4) { const f32x4 v = *(const LAS f32x4*)(Ld + L_UVT + (lane * TLD + 4 * t4) * 4); x[4 * t4] = v[0]; x[4 * t4 + 1] = v[1]; x[4 * t4 + 2] = v[2]; x[4 * t4 + 3] = v[3]; }
#pragma unroll
                for (int t = 0; t < 16; ++t) arow[t] = *(LAS float*)(Ld + L_AAB + 1024 + (t * 16 + c16) * 4);
                fwd_subst(x, arow);
#pragma unroll
                for (int t4 = 0; t4 < 4; ++t4) *(LAS f32x4*)(Ld + L_UVT + (lane * TLD + 4 * t4) * 4) = (f32x4){x[4 * t4], x[4 * t4 + 1], x[4 * t4 + 2], x[4 * t4 + 3]};
            } else if (q == 2) {
                const f32x4 rb = tile_xyT(Ld + L_RREF, Ld + L_BREF, lane);
                const f32x4 rk = tile_xyT(Ld + L_RREF, Ld + L_KREF, lane);
#pragma unroll
                for (int r = 0; r < 4; ++r) { const int t = 4 * g4 + r; const bool keep = (c16 <= t);
                    *(LAS f16*)(Ld + L_ARK + (t * 40 + 8 * (c16 >> 2) + (c16 & 3)) * 2) = (f16)(keep ? rb[r] : 0.f);
                    *(LAS f16*)(Ld + L_ARK + (t * 40 + 8 * (c16 >> 2) + 4 + (c16 & 3)) * 2) = (f16)(keep ? rk[r] : 0.f); }
            }
            }
            __syncthreads();
        }
        {
            const int n = NT; const int pbn = n & 1; (void)pbn;
            const int pbm = (n - 1) & 1, v3m = (n - 1) % 3;
            f16x8 sb[2];
#pragma unroll
            for (int ks = 0; ks < 2; ++ks) { u32x4 w; w.x = pk_f16(S[8 * ks], S[8 * ks + 1]); w.y = pk_f16(S[8 * ks + 2], S[8 * ks + 3]); w.z = pk_f16(S[8 * ks + 4], S[8 * ks + 5]); w.w = pk_f16(S[8 * ks + 6], S[8 * ks + 7]); sb[ks] = __builtin_bit_cast(f16x8, w); }
            const int il = 16 * q + c16;
            f32x4 U = *(const LAS f32x4*)(Ld + L_UVT + (il * TLD + 4 * g4) * 4);
            f32x4 Y = {0.f, 0.f, 0.f, 0.f};
            const int oa = (c16 * HLD + 8 * g4) * 2;
#pragma unroll
            for (int ks = 0; ks < 2; ++ks) {
                const f16x8 fap = *(const LAS f16x8*)(Ld + L_APR + oa + 64 * ks), fr0 = *(const LAS f16x8*)(Ld + L_R0 + pbm * 2304 + oa + 64 * ks);
                U = __builtin_amdgcn_mfma_f32_16x16x32_f16(fap, sb[ks], U, 0, 0, 0);
                Y = __builtin_amdgcn_mfma_f32_16x16x32_f16(fr0, sb[ks], Y, 0, 0, 0);
            }
            f16x8 uvb; { const u32x2 wv_ = *(const LAS u32x2*)(Ld + L_VT + v3m * 2560 + (il * TLD + 4 * g4) * 2); const u32x4 w4 = {pk_f16(U[0], U[1]), pk_f16(U[2], U[3]), wv_.x, wv_.y}; uvb = __builtin_bit_cast(f16x8, w4); }
            { const f16x8 fark = *(const LAS f16x8*)(Ld + L_ARK + (c16 * 40 + 8 * g4) * 2); Y = __builtin_amdgcn_mfma_f32_16x16x32_f16(fark, uvb, Y, 0, 0, 0); }
#pragma unroll
            for (int r = 0; r < 4; ++r) *(LAS float*)(Ld + L_YO + ((4 * g4 + r) * 68 + il) * 4) = Y[r];
#pragma unroll
            for (int jt = 0; jt < 4; ++jt) {
                const int jo = 32 * (jt >> 1) + 8 * (c16 >> 2) + 4 * (jt & 1) + (c16 & 3);
                const f16x8 fbk = *(const LAS f16x8*)(Ld + L_BKT + pbm * 5120 + (jo * 40 + 8 * g4) * 2);
                const f32x4 ec = *(const LAS f32x4*)(Ld + L_EC + pbm * 256 + (32 * (jt >> 1) + 8 * g4 + 4 * (jt & 1)) * 4);
                const int sbase = 8 * (jt >> 1) + 4 * (jt & 1);
                f32x4 cin = {S[sbase] * ec[0], S[sbase + 1] * ec[1], S[sbase + 2] * ec[2], S[sbase + 3] * ec[3]};
                cin = __builtin_amdgcn_mfma_f32_16x16x32_f16(fbk, uvb, cin, 0, 0, 0);
                S[sbase] = cin[0]; S[sbase + 1] = cin[1]; S[sbase + 2] = cin[2]; S[sbase + 3] = cin[3];
            }
        }
        __builtin_amdgcn_s_setprio(0);
        __syncthreads();
        if (!LAT) { float* sp = a.out + (size_t)M * D + sidx;
#pragma unroll
            for (int n = 0; n < 16; ++n) sp[perm_o(32 * (n >> 3) + 8 * g4 + (n & 7))] = S[n]; }
    }
    __syncthreads();
#undef STAGE_A
#undef FINALIZE
#undef MUV
}
__device__ __forceinline__ void scan_phase(const Args& a, int z, int l, LAS unsigned char* lds, int G, int bx, int tid, int wave, int lane, const unsigned* mid_cnt = nullptr) {
    if (G == 256) {
        const int d = (bx >> 3) & 1, p = (bx & 7) + 8 * (bx >> 4);
        if (p < 64) scan_chain<true>(a, z, l, lds, p, p >> 4, p & 15, d, tid, wave, lane, mid_cnt);
        else for (int u = p - 64; u < 512; u += 64) scan_chain<false>(a, z, l, lds, 64 + u, u >> 4, u & 15, d, tid, wave, lane);
    } else {
        const int d = bx & 1, np = G >> 1;
        if (bx < 2 * np) for (int u = bx >> 1; u < 576; u += np) { if (u < 64) scan_chain<true>(a, z, l, lds, u, u >> 4, u & 15, d, tid, wave, lane); else scan_chain<false>(a, z, l, lds, u, (u - 64) >> 4, (u - 64) & 15, d, tid, wave, lane); }
    }
}

constexpr int MX_LD = 272, MX_TB = 128 * MX_LD, MX_STAT = 2 * MX_TB;
__device__ __forceinline__ f16x4 tr_read(LAS unsigned char* p) { return __builtin_bit_cast(f16x4, __builtin_amdgcn_ds_read_tr16_b64_v4i16((LAS v4i16_t*)p)); }
__device__ __forceinline__ void mix_phase(const Args& a, int z, int l, LAS unsigned char* lds, int G, int bx, int tid, int wave, int lane) {
    f16* U16 = (f16*)(a.ws + WS_BIG + 48 * MiB); const f16* V16 = (const f16*)(a.ws + WS_BIG + 96 * MiB);
    const f16* ws16 = (const f16*)(a.ws + WS_SMALL + SM_WS) + (size_t)l * 8 * 128 * 128;
    const float* lnvg = a.in[z + I_LNVG] + l * 1024; const float* bs = a.in[z + I_BS] + l * 1024;
    LAS float* STAT = (LAS float*)(lds + MX_STAT);
    const int pl = 16 * wave + (lane & 15), g4 = lane >> 4;
    for (int unit = bx; unit < M / 128; unit += G) {
        const size_t r0 = (size_t)unit * 128;
        {
            f16x8 x[4][8];
#pragma unroll
            for (int ps = 0; ps < 4; ++ps) { const f16* p = V16 + (r0 + 16 * wave + 4 * ps + g4) * D + 8 * (lane & 15);
#pragma unroll
                for (int k = 0; k < 8; ++k) x[ps][k] = *(const f16x8*)(p + 128 * k); }
#pragma unroll
            for (int ps = 0; ps < 4; ++ps) { const int q = 16 * wave + 4 * ps + g4;
                float s = 0.f, s2 = 0.f;
#pragma unroll
                for (int k = 0; k < 8; ++k)
#pragma unroll
                    for (int e = 0; e < 8; ++e) { const float v = (float)x[ps][k][e]; s += v; s2 += v * v; }
                s = red16(s); s2 = red16(s2);
                const float mean = s * (1.0f / D); const float var = s2 * (1.0f / D) - mean * mean;
                if ((lane & 15) == 0) { STAT[2 * q] = mean; STAT[2 * q + 1] = __builtin_amdgcn_rsqf((var > 0.f ? var : 0.f) + EPS); } }
        }
        const int qs = tid >> 4, ch = tid & 15;
        f16x8 vreg[4]; u32x2 ureg[8]; f16x8 wfrag[4]; f32x4 gpre0, gpre1;
#define MIX_PREFETCH(hh) do { \
            _Pragma("unroll") for (int i = 0; i < 4; ++i) vreg[i] = *(const f16x8*)(V16 + (r0 + qs + 32 * i) * D + (hh) * 128 + 8 * ch); \
            _Pragma("unroll") for (int ct = 0; ct < 8; ++ct) ureg[ct] = *(const u32x2*)(U16 + (r0 + pl) * D + (hh) * 128 + 16 * ct + 4 * g4); \
            _Pragma("unroll") for (int ks = 0; ks < 4; ++ks) wfrag[ks] = *(const f16x8*)(ws16 + ((size_t)((hh) * 128 + pl)) * 128 + 32 * ks + 8 * g4); \
            gpre0 = *(const f32x4*)(lnvg + (hh) * 128 + 8 * ch); gpre1 = *(const f32x4*)(lnvg + (hh) * 128 + 8 * ch + 4); } while (0)
        MIX_PREFETCH(0);
        __syncthreads();
#pragma unroll 1
        for (int h = 0; h < 8; ++h) {
            LAS unsigned char* T = lds + (h & 1) * MX_TB;
            { const f32x4 g0 = gpre0, g1 = gpre1;
#pragma unroll
              for (int i = 0; i < 4; ++i) { const int q = qs + 32 * i; const float mean = STAT[2 * q], rstd = STAT[2 * q + 1]; const f16x8 x = vreg[i];
                u32x4 w; w.x = pk_f16(((float)x[0] - mean) * rstd * g0[0], ((float)x[1] - mean) * rstd * g0[1]); w.y = pk_f16(((float)x[2] - mean) * rstd * g0[2], ((float)x[3] - mean) * rstd * g0[3]);
                w.z = pk_f16(((float)x[4] - mean) * rstd * g1[0], ((float)x[5] - mean) * rstd * g1[1]); w.w = pk_f16(((float)x[6] - mean) * rstd * g1[2], ((float)x[7] - mean) * rstd * g1[3]);
                *(LAS u32x4*)(T + q * MX_LD + ch * 16) = w; } }
            u32x2 ucur[8]; f16x8 wcur[4];
#pragma unroll
            for (int ct = 0; ct < 8; ++ct) ucur[ct] = ureg[ct];
#pragma unroll
            for (int ks = 0; ks < 4; ++ks) wcur[ks] = wfrag[ks];
            const float bsv = bs[h * 128 + pl];
            { const int hn = (h + 1 < 8) ? h + 1 : 7; MIX_PREFETCH(hn); }
            __syncthreads();
            LAS unsigned char* tb = T + (8 * g4 + ((lane & 15) >> 2)) * MX_LD + (4 * (lane & 3)) * 2;
#pragma unroll
            for (int ct = 0; ct < 8; ++ct) {
                f32x4 acc = {0.f, 0.f, 0.f, 0.f};
#pragma unroll
                for (int ks = 0; ks < 4; ++ks) {
                    const f16x4 v1 = tr_read(tb + (32 * ks) * MX_LD + ct * 32), v2 = tr_read(tb + (32 * ks + 4) * MX_LD + ct * 32);
                    const f16x8 vf = {v1[0], v1[1], v1[2], v1[3], v2[0], v2[1], v2[2], v2[3]};
                    acc = __builtin_amdgcn_mfma_f32_16x16x32_f16(vf, wcur[ks], acc, 0, 0, 0);
                }
                const u32x2 uu = ucur[ct];
                u32x2 o; o.x = pk_f16(f16lo(uu.x) * (acc[0] + bsv), f16hi(uu.x) * (acc[1] + bsv)); o.y = pk_f16(f16lo(uu.y) * (acc[2] + bsv), f16hi(uu.y) * (acc[3] + bsv));
                *(u32x2*)(U16 + (r0 + pl) * D + h * 128 + 16 * ct + 4 * g4) = o;
            }
        }
#undef MIX_PREFETCH
        __syncthreads();
    }
}

constexpr int CW_BAR = 65536;
constexpr int LDSCTL_OFF = 131072 + 8192;
#define XB_TMO      128
#define XB_XCNT(j)  (256  + 64 * (j))
#define XB_XSUB(j)  (1280 + 64 * (j))
#define XB_XGEN(j)  (2304 + 64 * (j))
#define XB_TOP      3328
#define XB_TOPGEN   3392
#define XCD_BAR_WORDS 3456
#define XB_SPIN_CAP (1u << 18)

__device__ __forceinline__ unsigned xb_ld(unsigned* p)              { return __hip_atomic_load(p, __ATOMIC_RELAXED, __HIP_MEMORY_SCOPE_AGENT); }
__device__ __forceinline__ unsigned xb_add(unsigned* p, unsigned v) { return __hip_atomic_fetch_add(p, v, __ATOMIC_RELAXED, __HIP_MEMORY_SCOPE_AGENT); }
__device__ __forceinline__ unsigned xb_xcc_id() { return (unsigned)__builtin_amdgcn_s_getreg((3 << 11) | 20) & 0xFu; }
#define XB_SPIN(cond, bar) do { unsigned _sp = 0; while (cond) { __builtin_amdgcn_s_sleep(1); \
    if ((++_sp & 255u) == 0u) { if (xb_ld(&(bar)[XB_TMO])) break; if (_sp > XB_SPIN_CAP) { atomicAdd(&(bar)[XB_TMO], 1u); break; } } } } while (0)

struct XcdBarrier {
    unsigned* bar; unsigned x;
    volatile LAS unsigned* st;
};

__device__ __forceinline__ XcdBarrier xcd_barrier_post(unsigned* bar, volatile LAS unsigned* st) {
    XcdBarrier b; b.bar = bar; b.x = xb_xcc_id(); b.st = st;
    if (threadIdx.x == 0) (void)xb_add(&bar[XB_XCNT(b.x)], 1u);
    return b;
}
__device__ __forceinline__ void xcd_barrier_complete(unsigned* bar, unsigned x, unsigned& nloc, unsigned& nx) {
    const unsigned G = gridDim.x * gridDim.y * gridDim.z;
    unsigned sum, cnt, mine, sp = 0u;
    for (;;) {
        sum = 0u; cnt = 0u; mine = 0u;
#pragma unroll
        for (unsigned j = 0; j < 16; ++j) { const unsigned c = xb_ld(&bar[XB_XCNT(j)]); sum += c; cnt += (c > 0u) ? 1u : 0u; mine = (j == x) ? c : mine; }
        if (sum == G) break;
        __builtin_amdgcn_s_sleep(1);
        if ((++sp & 255u) == 0u) { if (xb_ld(&bar[XB_TMO])) break; if (sp > XB_SPIN_CAP) { atomicAdd(&bar[XB_TMO], 1u); break; } }
    }
    nloc = mine > 0u ? mine : 1u; nx = cnt > 0u ? cnt : 1u;
}

__device__ __forceinline__ void xcd_barrier(const XcdBarrier& b) {
    asm volatile("s_waitcnt vmcnt(0)" ::: "memory");
    __syncthreads();
    if (threadIdx.x == 0) {
        unsigned* bar = b.bar;
        __builtin_amdgcn_s_waitcnt(0);
        unsigned nloc = b.st[0], nx = b.st[1];
        if (nloc == 0u) { xcd_barrier_complete(bar, b.x, nloc, nx); b.st[0] = nloc; b.st[1] = nx; }
        const unsigned old = xb_add(&bar[XB_XSUB(b.x)], 1u);
        const unsigned gen = old / nloc;
        if (old + 1u == (gen + 1u) * nloc) {
            __builtin_amdgcn_fence(__ATOMIC_RELEASE, "agent");
            asm volatile("s_waitcnt vmcnt(0)" ::: "memory");
            const unsigned og = xb_add(&bar[XB_TOP], 1u);
            const unsigned tg = og / nx;
            if (og + 1u == (tg + 1u) * nx) xb_add(&bar[XB_TOPGEN], 1u);
            else XB_SPIN(xb_ld(&bar[XB_TOPGEN]) == tg, bar);
            __builtin_amdgcn_fence(__ATOMIC_ACQUIRE, "agent");
            xb_add(&bar[XB_XGEN(b.x)], 1u);
            asm volatile("s_waitcnt vmcnt(0)" ::: "memory");
        } else {
            XB_SPIN(xb_ld(&bar[XB_XGEN(b.x)]) == gen, bar);
            __builtin_amdgcn_fence(__ATOMIC_ACQUIRE, "agent");
            asm volatile("s_waitcnt vmcnt(0)" ::: "memory");
        }
    }
    __syncthreads();
}

#ifndef REP_P0
#define REP_P0 1
#endif
#ifndef REP_NORM
#define REP_NORM 1
#endif
#ifndef REP_SCAN
#define REP_SCAN 1
#endif
#ifndef REP_G1
#define REP_G1 1
#endif
#ifndef REP_G4
#define REP_G4 1
#endif
#ifndef REP_G7
#define REP_G7 1
#endif
#ifndef REP_G11
#define REP_G11 1
#endif
constexpr int PH_PER_LAYER = 14, NPHASES = 1 + NLAYER * PH_PER_LAYER + 1;
template <int ph> __device__ __forceinline__ void run_phase(const Args& a, LAS unsigned char* lds) {
    int tid = threadIdx.x; asm volatile("" : "+v"(tid));
    int bx = blockIdx.x; asm volatile("" : "+s"(bx));
    int G = gridDim.x; asm volatile("" : "+s"(G));
    int z = 0; asm volatile("" : "+s"(z));
    const int lane = tid & 63, wave = __builtin_amdgcn_readfirstlane(tid >> 6);
    const int gw = bx * NWAVES + wave, ngw = G * NWAVES;
    unsigned char* ws = a.ws;
    f16* W16 = (f16*)(ws + WS_W16);
    f16* RB = (f16*)(ws + WS_B);
    f16* BIG = (f16*)(ws + WS_BIG);
    f16* HB2 = BIG;
    f16* U16 = (f16*)(ws + WS_BIG + 48 * MiB);
    f16* G16 = (f16*)(ws + WS_BIG + 96 * MiB);
    float* X = a.out;
    const float* MOD = (const float*)(ws + WS_MOD);
    if (ph == 0) { for (int rep = 0; rep < REP_P0; ++rep) { p0_prologue(a, z, lds, G, bx, tid, wave, lane); __syncthreads(); } }
    else if (ph == NPHASES - 1) { final_norm_phase(X, a.in[z + I_FING], gw, ngw, lane); }
    else {
        constexpr int l = (ph - 1) / PH_PER_LAYER, k = (ph - 1) % PH_PER_LAYER;
        const float* modl = MOD + (size_t)l * 5 * 6144;
        float* xbuf = (float*)(ws + WS_BON + (size_t)M * 16 * 4); unsigned* ncnt = (unsigned*)(ws + WS_CTL) + 131072 + (size_t)(l * 2) * 96 * 64;
        constexpr bool x_in_out = (l > 0);
        const float* bc = x_in_out ? (const float*)X : a.in[z + I_XP];
        const float* bl = x_in_out ? (const float*)(X + (size_t)MCTX * D) : a.in[z + I_XS];
        if constexpr (k == 0) {
            if (l > 0) convert_layer_weights(a, z, l, lds, gw, ngw, wave, lane, bx * NTHR + tid, G * NTHR);
            if (l == 0 || G != 256) norm_phase(bc, bl, a.in[z + I_N1G] + l * D, modl, 0, 1, RB, gw, ngw, lane);
        } else if constexpr (k == 1) { pg8::Gemm g{RB, W16 + W_INR, M, ZRN, D}; pg8::EpiH16<0> E{BIG, ZRN, 0, 0};
            if (G == 256) { pg8::SeamOrder S; S.init(0, bx, nullptr); pg8::gemm_phase<pg8::EpiH16<0>, pg8::SeamOrder, true, true>(lds, g, S, E); }
            else { pg8::StaticOrder S; S.init(M, ZRN, G, bx); pg8::gemm_phase<pg8::EpiH16<0>, pg8::StaticOrder, true, true>(lds, g, S, E); }
        } else if constexpr (k == 2) {
            if (G == 256) {
                unsigned* c1 = (unsigned*)(ws + WS_CTL) + 49152 + l * 256; unsigned* c2 = c1 + 128;
                if (bx >= 128) {
                    pg8::Gemm g{RB, W16 + W_INR, M, ZRN, D}; pg8::EpiH16<0> E{BIG, ZRN, 0, 0}; pg8::SeamOrder S; S.init(1, bx - 128, c1);
                    pg8::gemm_phase<pg8::EpiH16<0>, pg8::SeamOrder, true, true>(lds, g, S, E);
                    asm volatile("s_waitcnt vmcnt(0)" ::: "memory"); __syncthreads();
                    if (tid == 0) { __builtin_amdgcn_fence(__ATOMIC_RELEASE, "agent"); asm volatile("s_waitcnt vmcnt(0)" ::: "memory"); (void)__hip_atomic_fetch_add(c2, 1u, __ATOMIC_RELAXED, __HIP_MEMORY_SCOPE_AGENT);
                        unsigned spins = 0; while (__hip_atomic_load(c2, __ATOMIC_RELAXED, __HIP_MEMORY_SCOPE_AGENT) < 128u) { __builtin_amdgcn_s_sleep(2); if (++spins > (1u << 24)) break; }
                        __builtin_amdgcn_fence(__ATOMIC_ACQUIRE, "agent"); asm volatile("s_waitcnt vmcnt(0)" ::: "memory"); }
                    __syncthreads();
                }
                scan_phase(a, z, l, lds, G, bx, tid, wave, lane, c1); __syncthreads();
            } else { scan_phase(a, z, l, lds, G, bx, tid, wave, lane); __syncthreads(); }
        } else if constexpr (k == 3) { if constexpr (l > 0) norm_phase(bc, bl, a.in[z + I_N1G] + l * D, modl, 0, 1, HB2, gw, ngw, lane);
        } else if constexpr (k == 4) { pg8::Gemm g{l == 0 ? RB : HB2, W16 + W_INUV, M, 2048, D}; pg8::StaticOrder S; S.init(M, 2048, G, bx); pg8::EpiH16<1> E{U16, D, 1024, (size_t)(48 * MiB / 2)};
            for (int rep = 0; rep < REP_G4; ++rep) pg8::gemm_phase<pg8::EpiH16<1>, pg8::StaticOrder, true, true>(lds, g, S, E);
        } else if constexpr (k == 5) { mix_phase(a, z, l, lds, G, bx, tid, wave, lane);
        } else if constexpr (k == 6) { pg8::Gemm g{l == 0 ? RB : HB2, W16 + W_ING, M, 2048, D}; pg8::StaticOrder S; S.init(M, 2048, G, bx); pg8::EpiH16<2> E{G16, 2048, 0, 0};
            pg8::gemm_phase<pg8::EpiH16<2>, pg8::StaticOrder, true, true>(lds, g, S, E);
        } else if constexpr (k == 7) { pg8::Gemm g7{l == 0 ? (const f16*)X : (const f16*)RB, W16 + W_A, M, D, D}; pg8::EpiMix<false> E7{HB2, G16, 0}; pg8::Gemm g8{U16, W16 + W_B, M, D, D}; pg8::EpiMix<true> E8{HB2, G16, 1024};
            if (G == 256) {
                if (bx < 128) { pg8::SubOrder S; S.init2(MCTX, D, 128, bx, 0, 0); pg8::gemm_phase<pg8::EpiMix<false>, pg8::SubOrder, true, true>(lds, g7, S, E7); pg8::gemm_phase<pg8::EpiMix<true>, pg8::SubOrder, true, true>(lds, g8, S, E8); }
                else { pg8::SubOrder S; S.init2(MLAT, D, 128, bx - 128, 32, 0); pg8::gemm_phase<pg8::EpiMix<false>, pg8::SubOrder, true, true>(lds, g7, S, E7); }
            } else { pg8::StaticOrder S; S.init(M, D, G, bx); pg8::gemm_phase<pg8::EpiMix<false>, pg8::StaticOrder, true, true>(lds, g7, S, E7); }
        } else if constexpr (k == 8) { pg8::Gemm g8{U16, W16 + W_B, M, D, D}; pg8::EpiMix<true> E8{HB2, G16, 1024};
            if (G == 256) {
                if (bx >= 128) { pg8::SubOrder S; S.init2(MLAT, D, 128, bx - 128, 32, 0); pg8::gemm_phase<pg8::EpiMix<true>, pg8::SubOrder, true, true>(lds, g8, S, E8); }
                else { pg8::Gemm g9{HB2, W16 + W_OUT, M, D, D}; pg8::EpiResNorm<false> E9{bc, bl, X, modl + 2 * 1024, RB, a.in[z + I_N2G] + l * D, modl, 3, 4, xbuf, ncnt, EPS}; pg8::SubOrder S; S.init2(MCTX, D, 128, bx, 0, 0);
                    pg8::gemm_phase<pg8::EpiResNorm<false>, pg8::SubOrder, true, true>(lds, g9, S, E9); }
            } else { pg8::StaticOrder S; S.init(M, D, G, bx); pg8::gemm_phase<pg8::EpiMix<true>, pg8::StaticOrder, true, true>(lds, g8, S, E8); }
        } else if constexpr (k == 9) { pg8::Gemm g{HB2, W16 + W_OUT, M, D, D}; pg8::EpiRes E{bc, bl, X, modl + 2 * 1024};
            if (G == 256) { pg8::EpiResNorm<false> EN{bc, bl, X, modl + 2 * 1024, RB, a.in[z + I_N2G] + l * D, modl, 3, 4, xbuf, ncnt, EPS}; pg8::SubOrder S; S.init2(MLAT, D, 256, bx, 32, 0);
                pg8::gemm_phase<pg8::EpiResNorm<false>, pg8::SubOrder, true, true>(lds, g, S, EN); }
            else { pg8::StaticOrder S; S.init(M, D, G, bx); pg8::gemm_phase<pg8::EpiRes, pg8::StaticOrder, true, true>(lds, g, S, E); }
        } else if constexpr (k == 10) { norm_phase(X, X + (size_t)MCTX * D, a.in[z + I_N2G] + l * D, modl, 3, 4, RB, gw, ngw, lane);
        } else if constexpr (k == 11) { pg8::Gemm g{RB, W16 + W_1, M, DFF, D}; pg8::EpiH16<3> E{BIG, DFF, 0, 0};
            if (G == 256) { pg8::EpiH16B<3> EB{BIG, DFF}; pg8::SubOrder S; S.init2(MCTX, DFF, 256, bx, 0, 0); pg8::gemm_phase<pg8::EpiH16B<3>, pg8::SubOrder, true, true>(lds, g, S, EB); }
            else { pg8::StaticOrder S; S.init(M, DFF, G, bx); pg8::gemm_phase<pg8::EpiH16<3>, pg8::StaticOrder, true, true>(lds, g, S, E); }
        } else if constexpr (k == 12) {
            if (G == 256) {
                { pg8::Gemm g{RB, W16 + W_1, M, DFF, D}; pg8::EpiH16B<3> E{BIG, DFF}; pg8::SubOrder S; S.init2(MLAT, DFF, 256, bx, 32, bx < 128 ? 1 : 2); pg8::gemm_phase<pg8::EpiH16B<3>, pg8::SubOrder, true, true>(lds, g, S, E); }
                if (bx >= 128) { __syncthreads(); pg8::Gemm g{BIG, W16 + W_2, M, D, DFF}; pg8::SubOrder S; S.init2(MCTX, D, 128, bx - 128, 0, 0);
                    if constexpr (l + 1 < NLAYER) { pg8::EpiResNorm<false> E{X, X + (size_t)MCTX * D, X, modl + 5 * 1024, RB, a.in[z + I_N1G] + (l + 1) * D, MOD + (size_t)(l + 1) * 5 * 6144, 0, 1, xbuf, ncnt + 96 * 64, EPS};
                        pg8::gemm_phase<pg8::EpiResNorm<false>, pg8::SubOrder, true, true, true>(lds, g, S, E); }
                    else { pg8::EpiResNorm<true> E{X, X + (size_t)MCTX * D, X, modl + 5 * 1024, nullptr, a.in[z + I_FING], nullptr, 0, 0, xbuf, ncnt + 96 * 64, EPS};
                        pg8::gemm_phase<pg8::EpiResNorm<true>, pg8::SubOrder, true, true, true>(lds, g, S, E); } }
            } else { pg8::Gemm g{BIG, W16 + W_2, M, D, DFF}; pg8::StaticOrder S; S.init(M, D, G, bx); pg8::EpiRes E{X, X + (size_t)MCTX * D, X, modl + 5 * 1024};
                pg8::gemm_phase<pg8::EpiRes, pg8::StaticOrder, true, true>(lds, g, S, E); }
        } else {
            if (G == 256) { pg8::Gemm g{BIG, W16 + W_2, M, D, DFF}; pg8::SubOrder S; S.init2(MLAT, D, 256, bx, 32, 0);
                if constexpr (l + 1 < NLAYER) { pg8::EpiResNorm<false> E{X, X + (size_t)MCTX * D, X, modl + 5 * 1024, RB, a.in[z + I_N1G] + (l + 1) * D, MOD + (size_t)(l + 1) * 5 * 6144, 0, 1, xbuf, ncnt + 96 * 64, EPS};
                    pg8::gemm_phase<pg8::EpiResNorm<false>, pg8::SubOrder, true, true, true>(lds, g, S, E); }
                else { pg8::EpiResNorm<true> E{X, X + (size_t)MCTX * D, X, modl + 5 * 1024, nullptr, a.in[z + I_FING], nullptr, 0, 0, xbuf, ncnt + 96 * 64, EPS};
                    pg8::gemm_phase<pg8::EpiResNorm<true>, pg8::SubOrder, true, true, true>(lds, g, S, E); } }
        }
    }
}
template <int ph> __device__ __forceinline__ void run_phases(const Args& a, LAS unsigned char* lds, cg::grid_group& grid, const XcdBarrier& bar) {
    if constexpr (ph < NPHASES) {
        constexpr bool empty_phase = (ph == 1 + 3);
        constexpr bool fused_norm_phase = (ph == NPHASES - 1) || (ph >= 1 && ph < NPHASES - 1 && (ph - 1) % PH_PER_LAYER == 10);
        const bool g256 = (gridDim.x == 256);
        if (!empty_phase && !(fused_norm_phase && g256) && a.ph_lo <= ph && ph < a.ph_hi) { run_phase<ph>(a, lds); if (ph + 1 < a.ph_hi && !(g256 && ph + 1 == NPHASES - 1)) { if (a.ph_lo > a.ph_hi) grid.sync(); else xcd_barrier(bar); } }
        run_phases<ph + 1>(a, lds, grid, bar);
    }
}
__global__ void __launch_bounds__(NTHR, 2) fwd_kernel(Args a) {
    extern __shared__ __attribute__((aligned(16))) unsigned char lds_raw[];
    LAS unsigned char* lds = (LAS unsigned char*)lds_raw;
    cg::grid_group grid = cg::this_grid();
    volatile LAS unsigned* bst = (volatile LAS unsigned*)(lds + LDSCTL_OFF);
    if (threadIdx.x < 2) bst[threadIdx.x] = 0u;
    __syncthreads();
    const XcdBarrier bar = xcd_barrier_post((unsigned*)(a.ws + WS_CTL) + CW_BAR, bst);
    run_phases<0>(a, lds, grid, bar);
}

extern "C" void kernel_launch(void* const* d_in, const int* in_sizes, int n_in, void* d_out, int out_size, void* d_ws, size_t ws_size, hipStream_t stream) {
    static int grid = 0;
    if (grid == 0) {
        if (n_in != N_IN || ws_size < WS_END) { fprintf(stderr, "kernel_launch: n_in %d (want %d), ws %zu (want >= %zu): nothing launched\n", n_in, (int)N_IN, ws_size, (size_t)WS_END); grid = -1; return; }
        int dev = 0, cus = 0, per_cu = 0;
        if (hipGetDevice(&dev) != hipSuccess || hipDeviceGetAttribute(&cus, hipDeviceAttributeMultiprocessorCount, dev) != hipSuccess) { grid = -1; return; }
        if (hipFuncSetAttribute((const void*)fwd_kernel, hipFuncAttributeMaxDynamicSharedMemorySize, LDS_BYTES) != hipSuccess) { fprintf(stderr, "kernel_launch: hipFuncSetAttribute failed\n"); grid = -1; return; }
        if (hipOccupancyMaxActiveBlocksPerMultiprocessor(&per_cu, (const void*)fwd_kernel, NTHR, LDS_BYTES) != hipSuccess || per_cu < 1) { fprintf(stderr, "kernel_launch: occupancy query says %d\n", per_cu); (void)hipGetLastError(); grid = -1; return; }
        grid = cus;
    }
    if (grid < 0) return;
    if (hipMemsetAsync((char*)d_ws + WS_CTL, 0, CTL_ZERO_BYTES, stream) != hipSuccess) { fprintf(stderr, "kernel_launch: memset failed\n"); return; }
    Args a{};
    for (int i = 0; i < N_IN; ++i) a.in[i] = (const float*)d_in[i];
    a.out = (float*)d_out; a.ws = (unsigned char*)d_ws;
#if MK_PER_PHASE
    for (int ph = 0; ph < NPHASES; ++ph) { a.ph_lo = ph; a.ph_hi = ph + 1; hipLaunchKernelGGL(fwd_kernel, dim3(grid), dim3(NTHR), LDS_BYTES, stream, a); }
#else
    a.ph_lo = 0; a.ph_hi = NPHASES;
    void* args[] = {&a};
    hipError_t e = hipLaunchCooperativeKernel((const void*)fwd_kernel, dim3(grid), dim3(NTHR), args, LDS_BYTES, stream);
    if (e != hipSuccess) fprintf(stderr, "kernel_launch: cooperative launch failed: %s (grid %d)\n", hipGetErrorString(e), grid);
#endif
}
```
